# Optimizing an MI355X kernel written in HIP

```python
import jax, jax.numpy as jnp
from jax import lax
import numpy as np

D_MODEL = 1024
BATCH = 4
SEQ = 4096
DEPTH = 2

MEM_LEN = 256
EPS = 1e-6
GM_GROUPS = 8
GM_GROUP_DIM = D_MODEL // GM_GROUPS
GM_WIDTH = GM_GROUPS * GM_GROUP_DIM
GM_CHUNK = 128
SSD_INNER = 2 * D_MODEL
SSD_HEAD_DIM = 64
SSD_HEADS = SSD_INNER // SSD_HEAD_DIM
SSD_GROUPS = 4
SSD_HPG = SSD_HEADS // SSD_GROUPS
SSD_STATE = 128
SSD_CONV = 4
SSD_CHUNK = 128
SSD_XBC = SSD_INNER + 2 * SSD_GROUPS * SSD_STATE
X_HEADS = 4
X_HEAD_DIM = D_MODEL // X_HEADS
FFN_DIM = 2816
FFN_CONV = 3
N_BRANCH = 2
IN_SIZES = (GM_WIDTH, GM_WIDTH, SSD_INNER, SSD_XBC, SSD_HEADS, D_MODEL, D_MODEL)
IN_COLS = sum(IN_SIZES)

kernel_name = "hybrid_gmlp_ssd_memxattn_convffn"


def rmsnorm(x, g):
    xf = x.astype(jnp.float32)
    y = xf * lax.rsqrt(jnp.mean(xf * xf, axis=-1, keepdims=True) + EPS)
    return (y * g.astype(jnp.float32)).astype(x.dtype)


def causal_dwconv(x, w, b):
    k_width = w.shape[0]
    s = x.shape[1]
    xp = jnp.pad(x, ((0, 0), (k_width - 1, 0), (0, 0)))
    y = b
    for k in range(k_width):
        y = y + xp[:, k:k + s, :] * w[k]
    return y


def gmlp_branch(u, v, v_gain, w_s, b_s):
    bsz, s, _ = v.shape
    n_chunks = s // GM_CHUNK
    u = jax.nn.gelu(u)
    v = rmsnorm(jax.nn.gelu(v), v_gain)
    vc = v.reshape(bsz, n_chunks, GM_CHUNK, GM_GROUPS, GM_GROUP_DIM)
    mask = jnp.tril(jnp.ones((GM_CHUNK, GM_CHUNK), dtype=w_s.dtype))
    ws = w_s * mask
    mixed = jnp.einsum('gts,bcsgd->bctgd', ws, vc) + b_s.T[None, None, :, :, None]
    return u * mixed.reshape(bsz, s, GM_WIDTH)


def ssd_branch(z, xbc, dt_raw, conv_w, conv_b, dt_bias, a_log, d_skip, norm_g):
    bsz, s, _ = z.shape
    nc, L = s // SSD_CHUNK, SSD_CHUNK
    G, R, P, N = SSD_GROUPS, SSD_HPG, SSD_HEAD_DIM, SSD_STATE
    xbc = jax.nn.silu(causal_dwconv(xbc, conv_w, conv_b))
    xs, bm, cm = jnp.split(xbc, [SSD_INNER, SSD_INNER + G * N], axis=-1)
    dt = jax.nn.softplus(dt_raw.astype(jnp.float32) + dt_bias.astype(jnp.float32))
    a = -jnp.exp(a_log.astype(jnp.float32))
    x = xs.reshape(bsz, nc, L, G, R, P)
    bc = bm.reshape(bsz, nc, L, G, N)
    cc = cm.reshape(bsz, nc, L, G, N)
    dt_c = dt.reshape(bsz, nc, L, G, R)
    xd = x * dt_c[..., None]
    a_cs = jnp.cumsum(jnp.moveaxis((dt * a).reshape(bsz, nc, L, G, R), 2, -1), axis=-1)
    causal = jnp.tril(jnp.ones((L, L), dtype=bool))
    seg = a_cs[..., :, None] - a_cs[..., None, :]
    lmat = jnp.exp(jnp.where(causal, seg, -jnp.inf))
    cb = jnp.einsum('bclgn,bcsgn->bcgls', cc, bc)
    scores = cb[:, :, :, None] * lmat
    y_diag = jnp.einsum('bcgrls,bcsgrp->bclgrp', scores, xd)
    decay = jnp.exp(a_cs[..., -1:] - a_cs)
    states = jnp.einsum('bcsgn,bcgrs,bcsgrp->bcgrpn', bc, decay, xd)
    chunk_decay = jnp.exp(a_cs[..., -1])

    def step(h, inp):
        st, dec = inp
        return h * dec[..., None, None] + st, h

    h0 = jnp.zeros_like(states[:, 0])
    _, prev = lax.scan(step, h0, (jnp.moveaxis(states, 1, 0), jnp.moveaxis(chunk_decay, 1, 0)))
    prev = jnp.moveaxis(prev, 0, 1)
    y_off = jnp.einsum('bclgn,bcgrpn->bclgrp', cc, prev) * jnp.exp(jnp.moveaxis(a_cs, -1, 2))[..., None]
    y = y_diag + y_off + x * d_skip.reshape(G, R)[:, :, None]
    y = y.reshape(bsz, s, SSD_INNER) * jax.nn.silu(z)
    yg = y.reshape(bsz, s, G, SSD_INNER // G)
    yf = yg.astype(jnp.float32)
    yf = yf * lax.rsqrt(jnp.mean(yf * yf, axis=-1, keepdims=True) + EPS)
    return (yf.reshape(bsz, s, SSD_INNER) * norm_g.astype(jnp.float32)).astype(y.dtype)


def mem_cross_attn(h, mem_n, w_q, w_kv, w_o):
    bsz, s, _ = h.shape
    m = mem_n.shape[1]
    q = (h @ w_q).reshape(bsz, s, X_HEADS, X_HEAD_DIM)
    k, v = jnp.split(mem_n @ w_kv, 2, axis=-1)
    k = k.reshape(bsz, m, X_HEADS, X_HEAD_DIM)
    v = v.reshape(bsz, m, X_HEADS, X_HEAD_DIM)
    sc = jnp.einsum('bshd,bmhd->bhsm', q, k).astype(jnp.float32) * (X_HEAD_DIM ** -0.5)
    p = jax.nn.softmax(sc, axis=-1).astype(v.dtype)
    o = jnp.einsum('bhsm,bmhd->bshd', p, v).reshape(bsz, s, D_MODEL)
    return o @ w_o


def conv_ffn(h, w_up, conv_w, conv_b, w_down):
    up = causal_dwconv(h @ w_up, conv_w, conv_b)
    a, b = jnp.split(up, 2, axis=-1)
    return (jax.nn.gelu(a) * b) @ w_down


def setup_inputs(seed: int = 0) -> dict:
    key = jax.random.key(seed)
    ks = iter(jax.random.split(key, 40))

    def nrm(shape, scale):
        return jax.random.normal(next(ks), shape, jnp.float32) * scale

    def gain(width):
        return 1.0 + nrm((DEPTH, width), 0.02)

    dt0 = jnp.exp(jax.random.uniform(next(ks), (DEPTH, SSD_HEADS), jnp.float32,
                                     np.log(1e-3), np.log(1e-1)))
    dt_bias = dt0 + jnp.log(-jnp.expm1(-dt0))
    a_log = jnp.log(jax.random.uniform(next(ks), (DEPTH, SSD_HEADS), jnp.float32, 1.0, 16.0))
    return {
        "x": nrm((BATCH, SEQ, D_MODEL), 1.0),
        "mem": nrm((BATCH, MEM_LEN, D_MODEL), 1.0),
        "norm_pre_mix": gain(D_MODEL),
        "norm_post_mix": gain(D_MODEL),
        "norm_pre_mem": gain(D_MODEL),
        "norm_mem_kv": gain(D_MODEL),
        "norm_post_mem": gain(D_MODEL),
        "norm_pre_ffn": gain(D_MODEL),
        "norm_post_ffn": gain(D_MODEL),
        "w_in": nrm((DEPTH, D_MODEL, IN_COLS), D_MODEL ** -0.5),
        "gm_v_norm": gain(GM_WIDTH),
        "gm_w_s": nrm((DEPTH, GM_GROUPS, GM_CHUNK, GM_CHUNK), GM_CHUNK ** -0.5),
        "gm_b_s": 1.0 + nrm((DEPTH, GM_GROUPS, GM_CHUNK), 0.02),
        "ssd_conv_w": nrm((DEPTH, SSD_CONV, SSD_XBC), SSD_CONV ** -0.5),
        "ssd_conv_b": nrm((DEPTH, SSD_XBC), 0.02),
        "ssd_dt_bias": dt_bias,
        "ssd_a_log": a_log,
        "ssd_d": 1.0 + nrm((DEPTH, SSD_HEADS), 0.02),
        "ssd_norm": gain(SSD_INNER),
        "w_branch_a": nrm((DEPTH, GM_WIDTH, D_MODEL), GM_WIDTH ** -0.5),
        "w_branch_b": nrm((DEPTH, SSD_INNER, D_MODEL), SSD_INNER ** -0.5),
        "w_out": nrm((DEPTH, D_MODEL, D_MODEL), D_MODEL ** -0.5),
        "xa_w_q": nrm((DEPTH, D_MODEL, D_MODEL), D_MODEL ** -0.5),
        "xa_w_kv": nrm((DEPTH, D_MODEL, 2 * D_MODEL), D_MODEL ** -0.5),
        "xa_w_o": nrm((DEPTH, D_MODEL, D_MODEL), D_MODEL ** -0.5),
        "ffn_w_up": nrm((DEPTH, D_MODEL, 2 * FFN_DIM), D_MODEL ** -0.5),
        "ffn_conv_w": nrm((DEPTH, FFN_CONV, 2 * FFN_DIM), FFN_CONV ** -0.5),
        "ffn_conv_b": nrm((DEPTH, 2 * FFN_DIM), 0.02),
        "ffn_w_down": nrm((DEPTH, FFN_DIM, D_MODEL), FFN_DIM ** -0.5),
    }


def reference(x, mem, norm_pre_mix, norm_post_mix, norm_pre_mem, norm_mem_kv, norm_post_mem,
              norm_pre_ffn, norm_post_ffn, w_in, gm_v_norm, gm_w_s, gm_b_s, ssd_conv_w, ssd_conv_b,
              ssd_dt_bias, ssd_a_log, ssd_d, ssd_norm, w_branch_a, w_branch_b, w_out,
              xa_w_q, xa_w_kv, xa_w_o, ffn_w_up, ffn_conv_w, ffn_conv_b, ffn_w_down):
    split_points = [int(i) for i in np.cumsum(IN_SIZES)[:-1]]
    for l in range(DEPTH):
        h = rmsnorm(x, norm_pre_mix[l])
        proj = h @ w_in[l]
        u, v, z, xbc, dt_raw, g_a, g_b = jnp.split(proj, split_points, axis=-1)
        y_a = gmlp_branch(u, v, gm_v_norm[l], gm_w_s[l], gm_b_s[l]) @ w_branch_a[l]
        y_b = ssd_branch(z, xbc, dt_raw, ssd_conv_w[l], ssd_conv_b[l], ssd_dt_bias[l],
                         ssd_a_log[l], ssd_d[l], ssd_norm[l]) @ w_branch_b[l]
        mixed = jax.nn.sigmoid(g_a) * y_a + jax.nn.sigmoid(g_b) * y_b
        x = x + rmsnorm(mixed @ w_out[l], norm_post_mix[l])
        h = rmsnorm(x, norm_pre_mem[l])
        mem_n = rmsnorm(mem, norm_mem_kv[l])
        x = x + rmsnorm(mem_cross_attn(h, mem_n, xa_w_q[l], xa_w_kv[l], xa_w_o[l]), norm_post_mem[l])
        h = rmsnorm(x, norm_pre_ffn[l])
        x = x + rmsnorm(conv_ffn(h, ffn_w_up[l], ffn_conv_w[l], ffn_conv_b[l], ffn_w_down[l]),
                        norm_post_ffn[l])
    return x
```

```cpp
#include <hip/hip_runtime.h>
#include <hip/hip_cooperative_groups.h>
#include <cstdio>
namespace cg = cooperative_groups;

#ifndef PER_PHASE_LAUNCH
#define PER_PHASE_LAUNCH 0

#endif

namespace pg8 {
#define PG8_LAS __attribute__((address_space(3)))
typedef unsigned short bf16_t;
typedef short bf16x8 __attribute__((ext_vector_type(8)));
typedef float f32x4 __attribute__((ext_vector_type(4)));
typedef unsigned u32x4 __attribute__((ext_vector_type(4)));
constexpr int BM = 256, BK = 64, HALF = 128, HTB = HALF * BK * 2  , STAGE_BYTES = 8 * HTB, NXCD = 8, WGM = 8;

__host__ __device__ __forceinline__ int lds_byte(int r, int c) { const int st = (r >> 4) * 2 + (c >> 5), rr = r & 15, cc = c & 31, ob = rr * 64 + cc * 2; return st * 1024 + (ob ^ (((ob >> 9) & 1) << 5)); }
__host__ __device__ __forceinline__ void stage_rc(int b, int& R, int& C) { const int st = b / 1024, sb = b % 1024, swz = sb ^ (((sb >> 9) & 1) << 5); R = (st >> 1) * 16 + swz / 64; C = (st & 1) * 32 + (swz % 64) / 2; }
__host__ __device__ __forceinline__ int perm32(int rho) { const int n = rho >> 4, i = rho & 15; return 8 * (i >> 2) + 4 * n + (i & 3); }

struct Unit { int pm, pn; };
struct Gemm { const bf16_t* A; const bf16_t* Bt; int M, N, K; };

struct StaticOrder {
    int nM, nN, nwg, G, c;
    __host__ __device__ void init(int M, int N, int G_, int c_) { nM = M / BM; nN = N / BM; nwg = nM * nN; G = G_; c = c_; }
    int nextra = 0, xm = 1, pm0 = 0, pn0 = 0; const char* A2 = nullptr; const char* B2 = nullptr;
    __device__ __forceinline__ const char* abase(const Gemm& g, const Unit& u, size_t tstep) const { return u.pn >= pn0 && nextra ? A2 + (size_t)(u.pm - pm0) * tstep : (const char*)g.A + (size_t)u.pm * tstep; }
    __device__ __forceinline__ const char* bbase(const Gemm& g, const Unit& u, size_t tstep) const { return u.pn >= pn0 && nextra ? B2 + (size_t)(u.pn - pn0) * tstep : (const char*)g.Bt + (size_t)u.pn * tstep; }
    __host__ __device__ bool next(int i, Unit& u) const {
        const long L = (long)i * G + c; if (L >= nwg + nextra) return false;
        if (L >= nwg) { const int k = (int)(L - nwg); u.pm = pm0 + k % xm; u.pn = pn0 + k / xm; return true; }
        int wgid = (int)L; { const int q = nwg / NXCD, r = nwg % NXCD, xcd = wgid % NXCD, off = wgid / NXCD; wgid = (xcd < r ? xcd * (q + 1) : r * (q + 1) + (xcd - r) * q) + off; }
        const int nig = WGM * nN, gid = wgid / nig, fm = gid * WGM, gsz = (nM - fm) < WGM ? (nM - fm) : WGM;
        u.pm = fm + ((wgid % nig) % gsz); u.pn = (wgid % nig) / gsz; return true;
    }
    __device__ __forceinline__ void a_ready(const Unit&) const {}
    __device__ __forceinline__ void done(const Unit&) const {}
};
template <class Epi, class Sched>
__device__ __forceinline__ void gemm_phase(PG8_LAS unsigned char* lds, const Gemm g, const Sched& S, const Epi& E) {
    int tid = threadIdx.x; asm volatile("" : "+v"(tid)); const int wid = __builtin_amdgcn_readfirstlane(tid >> 6), lane = tid & 63, wr = wid >> 2, wc = wid & 3, fr = lane & 15, fq = lane >> 4;
    const int K = g.K, nt = K / BK;
    unsigned voffA[2], voffB[2];
#pragma unroll
    for (int i = 0; i < 2; ++i) { int R, C; stage_rc(tid * 16 + i * 8192, R, C); const int Rb = Epi::PERM ? ((R & ~31) + perm32(R & 31)) : R;
        voffA[i] = (unsigned)(R * K + C) * 2u; voffB[i] = (unsigned)(Rb * K + C) * 2u; }
    const size_t kstep = (size_t)(BK * 2);
    const size_t hstep = (size_t)HALF * K * 2;
    const size_t tstep = 2 * hstep;
    const unsigned ldsw = (unsigned)wid * 1024u;
    const int aoff = lds_byte(wr * 64 + fr, fq * 8), boff = lds_byte(wc * 32 + fr, fq * 8);
#define PG8_SA(b, h) (((b) * 2 + (h)) * HTB)
#define PG8_SB(b, h) ((4 + (b) * 2 + (h)) * HTB)
#define PG8_STAGE(bufoff, gbase, voff) do { _Pragma("unroll") for (int _i = 0; _i < 2; ++_i) \
        __builtin_amdgcn_global_load_lds((const unsigned*)((const char*)(gbase) + (voff)[_i]), (PG8_LAS unsigned*)(lds + (bufoff) + ldsw + _i * 8192), 16, 0, 0); } while (0)
#define PG8_LDA(dst, b, h) do { _Pragma("unroll") for (int m = 0; m < 4; ++m) _Pragma("unroll") for (int k = 0; k < 2; ++k) dst[m][k] = *(const PG8_LAS bf16x8*)(lds + PG8_SA(b, h) + aoff + m * 2048 + k * 1024); } while (0)
#define PG8_LDB(dst, b, h) do { _Pragma("unroll") for (int n = 0; n < 2; ++n) _Pragma("unroll") for (int k = 0; k < 2; ++k) dst[n][k] = *(const PG8_LAS bf16x8*)(lds + PG8_SB(b, h) + boff + n * 2048 + k * 1024); } while (0)
#define PG8_MMA(ai, bj, At, Bt) do { __builtin_amdgcn_s_setprio(1); _Pragma("unroll") for (int m = 0; m < 4; ++m) _Pragma("unroll") for (int n = 0; n < 2; ++n) _Pragma("unroll") for (int k = 0; k < 2; ++k) \
        acc[ai][bj][m][n] = __builtin_amdgcn_mfma_f32_16x16x32_bf16(Bt[n][k], At[m][k], acc[ai][bj][m][n], 0, 0, 0); __builtin_amdgcn_s_setprio(0); } while (0)
#define PG8_WAIT_V(n) asm volatile("s_waitcnt vmcnt(" #n ")" ::: "memory")
#define PG8_WAIT_L(n) asm volatile("s_waitcnt lgkmcnt(" #n ")" ::: "memory")
#define PG8_BAR __builtin_amdgcn_s_barrier()
#define PG8_SCHED __builtin_amdgcn_sched_barrier(0)
    Unit cur, nxt; int ui = 0;
    if (!S.next(0, cur)) return;
    f32x4 acc[2][2][4][2];
#pragma unroll
    for (int a = 0; a < 2; ++a)
#pragma unroll
        for (int b = 0; b < 2; ++b)
#pragma unroll
            for (int m = 0; m < 4; ++m)
#pragma unroll
                for (int n = 0; n < 2; ++n) acc[a][b][m][n] = (f32x4){0.f, 0.f, 0.f, 0.f};
    bf16x8 At[4][2], B0[2][2], B1[2][2];
    const char* cA = S.abase(g, cur, tstep); const char* cB = S.bbase(g, cur, tstep);
    S.a_ready(cur);
    PG8_STAGE(PG8_SB(0, 0), cB, voffB); PG8_STAGE(PG8_SA(0, 0), cA, voffA); PG8_STAGE(PG8_SB(0, 1), cB + hstep, voffB); PG8_STAGE(PG8_SA(0, 1), cA + hstep, voffA);
    if (wr == 1) PG8_BAR;
    PG8_WAIT_V(4); PG8_BAR;
    PG8_STAGE(PG8_SB(1, 0), cB + kstep, voffB); PG8_STAGE(PG8_SA(1, 0), cA + kstep, voffA); PG8_STAGE(PG8_SB(1, 1), cB + hstep + kstep, voffB);
    PG8_WAIT_V(6); PG8_BAR;
    for (;;) {
        const bool has_next = S.next(ui + 1, nxt);
        const char* nA = has_next ? S.abase(g, nxt, tstep) : cA; const char* nB = has_next ? S.bbase(g, nxt, tstep) : cB;
        for (int t = 0; t < nt; t += 2) {
            const bool last = (t == nt - 2);
            const char* a1 = cA + (size_t)(t + 1) * kstep;
            const char* a2 = last ? nA : cA + (size_t)(t + 2) * kstep; const char* b2 = last ? nB : cB + (size_t)(t + 2) * kstep;
            const char* a3 = a2 + kstep; const char* b3 = b2 + kstep;
            if (last && has_next) S.a_ready(nxt);
            PG8_LDB(B0, 0, 0); PG8_SCHED; PG8_LDA(At, 0, 0); PG8_STAGE(PG8_SA(1, 1), a1 + hstep, voffA);
            PG8_WAIT_L(8); PG8_BAR; PG8_WAIT_L(0); PG8_MMA(0, 0, At, B0); PG8_BAR; PG8_SCHED;
            PG8_LDB(B1, 0, 1); PG8_STAGE(PG8_SB(0, 0), b2, voffB);
            PG8_BAR; PG8_WAIT_L(0); PG8_MMA(0, 1, At, B1); PG8_BAR;
            PG8_LDA(At, 0, 1); PG8_STAGE(PG8_SA(0, 0), a2, voffA);
            PG8_BAR; PG8_WAIT_L(0); PG8_MMA(1, 0, At, B0); PG8_BAR; PG8_SCHED;
            PG8_STAGE(PG8_SB(0, 1), b2 + hstep, voffB);
            PG8_WAIT_V(6); PG8_BAR; PG8_MMA(1, 1, At, B1); PG8_BAR;
            PG8_LDB(B0, 1, 0); PG8_SCHED; PG8_LDA(At, 1, 0); PG8_STAGE(PG8_SA(0, 1), a2 + hstep, voffA);
            PG8_WAIT_L(8); PG8_BAR; PG8_WAIT_L(0); PG8_MMA(0, 0, At, B0); PG8_BAR; PG8_SCHED;
            PG8_LDB(B1, 1, 1); PG8_STAGE(PG8_SB(1, 0), b3, voffB);
            PG8_BAR; PG8_WAIT_L(0); PG8_MMA(0, 1, At, B1); PG8_BAR;
            PG8_LDA(At, 1, 1); PG8_STAGE(PG8_SA(1, 0), a3, voffA);
            PG8_BAR; PG8_WAIT_L(0); PG8_MMA(1, 0, At, B0); PG8_BAR; PG8_SCHED;
            PG8_STAGE(PG8_SB(1, 1), b3 + hstep, voffB);
            PG8_WAIT_V(6); PG8_BAR; PG8_MMA(1, 1, At, B1); PG8_BAR;
        }
        if constexpr (!Epi::AFTER_DRAIN) { E(acc, cur, wr, wc, fr, fq); S.done(cur); }
        if (!has_next) break;
#pragma unroll
        for (int a = 0; a < 2; ++a)
#pragma unroll
            for (int b = 0; b < 2; ++b)
#pragma unroll
                for (int m = 0; m < 4; ++m)
#pragma unroll
                    for (int n = 0; n < 2; ++n) acc[a][b][m][n] = (f32x4){0.f, 0.f, 0.f, 0.f};
        cur = nxt; cA = nA; cB = nB; ++ui;
    }
    PG8_WAIT_V(0);
    if (wr == 0) PG8_BAR;
    PG8_BAR;
    if constexpr (Epi::AFTER_DRAIN) { E.fused(acc, cur, wr, wc, fr, fq, lds, wid, lane); S.done(cur); }
#undef PG8_SA
#undef PG8_SB
#undef PG8_STAGE
#undef PG8_LDA
#undef PG8_LDB
#undef PG8_MMA
#undef PG8_WAIT_V
#undef PG8_WAIT_L
#undef PG8_BAR
#undef PG8_SCHED
}
}

#define LAS __attribute__((address_space(3)))
typedef unsigned short bf16_t;
typedef short bf16x8 __attribute__((ext_vector_type(8)));
typedef float f32x4 __attribute__((ext_vector_type(4)));
typedef unsigned u32x4 __attribute__((ext_vector_type(4)));
typedef unsigned u32x2 __attribute__((ext_vector_type(2)));

constexpr int T_TOK = 16384, DM = 1024;
constexpr size_t SL = 32ull << 20;
#define OFF_A(i) ((size_t)(i) * SL)
constexpr size_t OFF_W = 8 * SL, OFF_DT = OFF_W + (24ull << 20), OFF_VSQ = OFF_DT + (2ull << 20), OFF_CDEC = OFF_VSQ + (1ull << 20), OFF_BAR = OFF_CDEC + 65536, OFF_XCNT = OFF_BAR + 16384, OFF_XBUF = OFF_XCNT + 12 * 64 * 256, WS_END = OFF_XBUF + 12 * 64 * 256 * 4 * 4;
constexpr size_t MiB = 1ull << 20;
constexpr size_t OFF_KV = OFF_W + 18 * MiB, OFF_WKV = OFF_A(7), OFF_MEMN = OFF_A(7) + 4 * MiB;
constexpr int LDS_MISC = 149504, LDS_BYTES = LDS_MISC + 16;
constexpr float EPS = 1e-6f;

typedef float f32x2_t __attribute__((ext_vector_type(2)));
typedef __bf16 bf16x2_t __attribute__((ext_vector_type(2)));
__device__ __forceinline__ unsigned pk2(float lo, float hi) { const f32x2_t v = {lo, hi}; const bf16x2_t b = __builtin_convertvector(v, bf16x2_t); return __builtin_bit_cast(unsigned, b); }
__device__ __forceinline__ float bflo(unsigned w) { return __uint_as_float(w << 16); }
__device__ __forceinline__ float bfhi(unsigned w) { return __uint_as_float(w & 0xffff0000u); }
__device__ __forceinline__ float sigmoid_f(float x) { return __fdividef(1.f, 1.f + __expf(-x)); }
__device__ __forceinline__ float silu_f(float x) { return x * sigmoid_f(x); }
__device__ __forceinline__ float gelu_f(float x) { const float y = 1.5957691216f * (x + 0.044715f * x * x * x); return x * sigmoid_f(y); }
__device__ __forceinline__ float softplus_f(float x) { return fmaxf(x, 0.f) + log1pf(__expf(-fabsf(x))); }
__device__ __forceinline__ float wave_sum(float v) {
#pragma unroll
    for (int o = 1; o < 64; o <<= 1) v += __shfl_xor(v, o);
    return v;
}
__device__ __forceinline__ f32x4 mfma16(bf16x8 a, bf16x8 b, f32x4 c) { return __builtin_amdgcn_mfma_f32_16x16x32_bf16(a, b, c, 0, 0, 0); }
__device__ __forceinline__ bf16x8 frag_row(const LAS unsigned char* base, int strideB, int r0, int k0, int lane) {
    return *(const LAS bf16x8*)(base + (r0 + (lane & 15)) * strideB + (k0 + 8 * (lane >> 4)) * 2);
}
__device__ __forceinline__ bf16x8 frag_tr_gen(unsigned base_addr, int strideB, int k0, int c0, int lane, int grp_step, int second_off) {
    const int g = lane >> 4, q = (lane & 15) >> 2, p = lane & 3;
    const unsigned a0 = base_addr + (unsigned)((k0 + grp_step * g + q) * strideB + (c0 + 4 * p) * 2);
    const unsigned a1 = a0 + (unsigned)(second_off * strideB);
    u32x2 lo, hi;
    asm volatile("ds_read_b64_tr_b16 %0, %2\n\tds_read_b64_tr_b16 %1, %3\n\ts_waitcnt lgkmcnt(0)" : "=&v"(lo), "=&v"(hi) : "v"(a0), "v"(a1) : "memory");
    u32x4 r; r.x = lo.x; r.y = lo.y; r.z = hi.x; r.w = hi.y;
    return __builtin_bit_cast(bf16x8, r);
}
__device__ __forceinline__ bf16x8 frag_tr(unsigned base_addr, int strideB, int k0, int c0, int lane) { return frag_tr_gen(base_addr, strideB, k0, c0, lane, 8, 4); }
__device__ __forceinline__ unsigned lds_addr(const LAS unsigned char* p) { return (unsigned)(unsigned long long)(const LAS void*)p; }


#define PPERM(i) (32 * ((i) >> 1) + 4 * ((i) & 1))
template <bool PERM = false>
__device__ __forceinline__ void frag_tr_x4(unsigned base_addr, int strideB, int k0, int c0, int cstep, int lane, int grp_step, int second_off, bf16x8 (&out)[4]) {
    const int g = lane >> 4, q = (lane & 15) >> 2, p = lane & 3;
    const unsigned a0 = base_addr + (unsigned)((k0 + grp_step * g + q) * strideB + (c0 + (PERM ? 8 : 4) * p) * 2), b0 = a0 + (unsigned)(second_off * strideB), cs = (unsigned)(cstep * 2);
    if (PERM) {
        u32x2 l0, h0, l1, h1, l2, h2, l3, h3;
        asm volatile("ds_read_b64_tr_b16 %0, %8\n\tds_read_b64_tr_b16 %1, %9\n\tds_read_b64_tr_b16 %2, %10\n\tds_read_b64_tr_b16 %3, %11\n\t"
                     "ds_read_b64_tr_b16 %4, %12\n\tds_read_b64_tr_b16 %5, %13\n\tds_read_b64_tr_b16 %6, %14\n\tds_read_b64_tr_b16 %7, %15\n\ts_waitcnt lgkmcnt(0)"
                     : "=&v"(l0), "=&v"(h0), "=&v"(l1), "=&v"(h1), "=&v"(l2), "=&v"(h2), "=&v"(l3), "=&v"(h3)
                     : "v"(a0), "v"(b0), "v"(a0 + 8u), "v"(b0 + 8u), "v"(a0 + 64u), "v"(b0 + 64u), "v"(a0 + 72u), "v"(b0 + 72u) : "memory");
        u32x4 r;
        r.x = l0.x; r.y = l0.y; r.z = h0.x; r.w = h0.y; out[0] = __builtin_bit_cast(bf16x8, r);
        r.x = l1.x; r.y = l1.y; r.z = h1.x; r.w = h1.y; out[1] = __builtin_bit_cast(bf16x8, r);
        r.x = l2.x; r.y = l2.y; r.z = h2.x; r.w = h2.y; out[2] = __builtin_bit_cast(bf16x8, r);
        r.x = l3.x; r.y = l3.y; r.z = h3.x; r.w = h3.y; out[3] = __builtin_bit_cast(bf16x8, r);
        return;
    }
    u32x2 l0, h0, l1, h1, l2, h2, l3, h3;
    asm volatile("ds_read_b64_tr_b16 %0, %8\n\tds_read_b64_tr_b16 %1, %9\n\tds_read_b64_tr_b16 %2, %10\n\tds_read_b64_tr_b16 %3, %11\n\t"
                 "ds_read_b64_tr_b16 %4, %12\n\tds_read_b64_tr_b16 %5, %13\n\tds_read_b64_tr_b16 %6, %14\n\tds_read_b64_tr_b16 %7, %15\n\ts_waitcnt lgkmcnt(0)"
                 : "=&v"(l0), "=&v"(h0), "=&v"(l1), "=&v"(h1), "=&v"(l2), "=&v"(h2), "=&v"(l3), "=&v"(h3)
                 : "v"(a0), "v"(b0), "v"(a0 + cs), "v"(b0 + cs), "v"(a0 + 2 * cs), "v"(b0 + 2 * cs), "v"(a0 + 3 * cs), "v"(b0 + 3 * cs) : "memory");
    u32x4 r;
    r.x = l0.x; r.y = l0.y; r.z = h0.x; r.w = h0.y; out[0] = __builtin_bit_cast(bf16x8, r);
    r.x = l1.x; r.y = l1.y; r.z = h1.x; r.w = h1.y; out[1] = __builtin_bit_cast(bf16x8, r);
    r.x = l2.x; r.y = l2.y; r.z = h2.x; r.w = h2.y; out[2] = __builtin_bit_cast(bf16x8, r);
    r.x = l3.x; r.y = l3.y; r.z = h3.x; r.w = h3.y; out[3] = __builtin_bit_cast(bf16x8, r);
}


#define XB_TMO      128
#define XB_XCNT(j)  (256  + 64 * (j))
#define XB_XSUB(j)  (1280 + 64 * (j))
#define XB_XGEN(j)  (2304 + 64 * (j))
#define XB_TOP      3328
#define XB_TOPGEN   3392
#define XCD_BAR_WORDS 3456
#define XB_SPIN_CAP (1u << 18)

__device__ __forceinline__ unsigned xb_ld(unsigned* p)              { return __hip_atomic_load(p, __ATOMIC_RELAXED, __HIP_MEMORY_SCOPE_AGENT); }
__device__ __forceinline__ unsigned xb_add(unsigned* p, unsigned v) { return __hip_atomic_fetch_add(p, v, __ATOMIC_RELAXED, __HIP_MEMORY_SCOPE_AGENT); }
__device__ __forceinline__ unsigned xb_xcc_id() { return (unsigned)__builtin_amdgcn_s_getreg((3 << 11) | 20) & 0xFu; }
#define XB_SPIN(cond, bar) do { unsigned _sp = 0; while (cond) { __builtin_amdgcn_s_sleep(1); \
    if ((++_sp & 255u) == 0u) { if (xb_ld(&(bar)[XB_TMO])) break; if (_sp > XB_SPIN_CAP) { atomicAdd(&(bar)[XB_TMO], 1u); break; } } } } while (0)

struct XcdBarrier {
    unsigned* bar; unsigned x;
    volatile LAS unsigned* st;
};

__device__ __forceinline__ XcdBarrier xcd_barrier_post(unsigned* bar, volatile LAS unsigned* st) {
    XcdBarrier b; b.bar = bar; b.x = xb_xcc_id(); b.st = st;
    if (threadIdx.x == 0) (void)xb_add(&bar[XB_XCNT(b.x)], 1u);
    return b;
}
__device__ __forceinline__ void xcd_barrier_complete(unsigned* bar, unsigned x, unsigned& nloc, unsigned& nx) {
    const unsigned G = gridDim.x * gridDim.y * gridDim.z;
    unsigned sum, cnt, mine, sp = 0u;
    for (;;) {
        sum = 0u; cnt = 0u; mine = 0u;
#pragma unroll
        for (unsigned j = 0; j < 16; ++j) { const unsigned c = xb_ld(&bar[XB_XCNT(j)]); sum += c; cnt += (c > 0u) ? 1u : 0u; mine = (j == x) ? c : mine; }
        if (sum == G) break;
        __builtin_amdgcn_s_sleep(1);
        if ((++sp & 255u) == 0u) { if (xb_ld(&bar[XB_TMO])) break; if (sp > XB_SPIN_CAP) { atomicAdd(&bar[XB_TMO], 1u); break; } }
    }
    nloc = mine > 0u ? mine : 1u; nx = cnt > 0u ? cnt : 1u;
}

__device__ __forceinline__ void xcd_barrier(const XcdBarrier& b) {
    asm volatile("s_waitcnt vmcnt(0)" ::: "memory");
    __syncthreads();
    if (threadIdx.x == 0) {
        unsigned* bar = b.bar;
        __builtin_amdgcn_s_waitcnt(0);
        unsigned nloc = b.st[0], nx = b.st[1];
        if (nloc == 0u) { xcd_barrier_complete(bar, b.x, nloc, nx); b.st[0] = nloc; b.st[1] = nx; }
        const unsigned old = xb_add(&bar[XB_XSUB(b.x)], 1u);
        const unsigned gen = old / nloc;
        if (old + 1u == (gen + 1u) * nloc) {
            __builtin_amdgcn_fence(__ATOMIC_RELEASE, "agent");
            asm volatile("s_waitcnt vmcnt(0)" ::: "memory");
            const unsigned og = xb_add(&bar[XB_TOP], 1u);
            const unsigned tg = og / nx;
            if (og + 1u == (tg + 1u) * nx) xb_add(&bar[XB_TOPGEN], 1u);
            else XB_SPIN(xb_ld(&bar[XB_TOPGEN]) == tg, bar);
            __builtin_amdgcn_fence(__ATOMIC_ACQUIRE, "agent");
            xb_add(&bar[XB_XGEN(b.x)], 1u);
            asm volatile("s_waitcnt vmcnt(0)" ::: "memory");
        } else {
            XB_SPIN(xb_ld(&bar[XB_XGEN(b.x)]) == gen, bar);
            __builtin_amdgcn_fence(__ATOMIC_ACQUIRE, "agent");
            asm volatile("s_waitcnt vmcnt(0)" ::: "memory");
        }
    }
    __syncthreads();
}

struct Args { const float* in[29]; float* out; unsigned char* ws; int lo, hi; };

enum { M_NONE = 0, M_GELU, M_GELUSQ, M_SIGMOID, M_SILU, M_DT, M_MULG, M_ADDMULG };
struct GD { unsigned long long a, b, aux; unsigned long long o[4]; int pb[4], m[4], ld[4]; int M, N, K, isgemm; };
struct EpiGen {
    static constexpr bool PERM = true, AFTER_DRAIN = false;
    const GD* d; unsigned char* ws;
    float* f32o; const float* bias; float* sq;
    template <int MODE> __device__ __forceinline__ void run(const f32x4 (&acc)[2][2][4][2], bf16_t* base, const bf16_t* aux, int ld, int row0, int col0, int pnl, int wc, int fq) const {
#pragma unroll
        for (int ai = 0; ai < 2; ++ai) {
            u32x4 gall[4][2], aall[4][2];
#pragma unroll
            for (int m = 0; m < 4; ++m) {
                if ((m & 1) == 0) {
                    if (MODE == M_MULG || MODE == M_ADDMULG) {
#pragma unroll
                        for (int mm = m; mm < m + 2; ++mm) { const bf16_t* rp = base + (size_t)(row0 + ai * 128 + mm * 16) * ld + col0; gall[mm][0] = *(const u32x4*)(rp); gall[mm][1] = *(const u32x4*)(rp + 128); }
                    }
                    if (MODE == M_ADDMULG) {
#pragma unroll
                        for (int mm = m; mm < m + 2; ++mm) { const bf16_t* rp = aux + (size_t)(row0 + ai * 128 + mm * 16) * ld + col0; aall[mm][0] = *(const u32x4*)(rp); aall[mm][1] = *(const u32x4*)(rp + 128); }
                    }
                }
                const size_t row = (size_t)(row0 + ai * 128 + m * 16);
                bf16_t* rowp = base + row * ld + col0;
                float sqs = 0.f;
                u32x4 gld[2], ald[2];
                if (MODE == M_MULG || MODE == M_ADDMULG) { gld[0] = gall[m][0]; gld[1] = gall[m][1]; }
                if (MODE == M_ADDMULG) { ald[0] = aall[m][0]; ald[1] = aall[m][1]; }
#pragma unroll
                for (int bj = 0; bj < 2; ++bj) {
                    f32x4 v0 = acc[ai][bj][m][0], v1 = acc[ai][bj][m][1];
                    if (MODE == M_DT) {
                        if (bj == 0 && wc == 0) {
                            const f32x4 b0 = *(const f32x4*)(bias + 8 * fq), b1 = *(const f32x4*)(bias + 8 * fq + 4);
                            f32x4 r0, r1;
#pragma unroll
                            for (int e = 0; e < 4; ++e) { r0[e] = softplus_f(v0[e] + b0[e]); r1[e] = softplus_f(v1[e] + b1[e]); }
                            *(f32x4*)(f32o + row * 32 + 8 * fq) = r0; *(f32x4*)(f32o + row * 32 + 8 * fq + 4) = r1;
                        }
                        continue;
                    }
#pragma unroll
                    for (int e = 0; e < 4; ++e) {
                        if (MODE == M_GELU || MODE == M_GELUSQ) { v0[e] = gelu_f(v0[e]); v1[e] = gelu_f(v1[e]); }
                        if (MODE == M_SIGMOID) { v0[e] = sigmoid_f(v0[e]); v1[e] = sigmoid_f(v1[e]); }
                        if (MODE == M_SILU) { v0[e] = silu_f(v0[e]); v1[e] = silu_f(v1[e]); }
                        if (MODE == M_GELUSQ) sqs += v0[e] * v0[e] + v1[e] * v1[e];
                    }
                    if (MODE == M_MULG || MODE == M_ADDMULG) {
                        const u32x4 g = gld[bj];
                        v0[0] *= bflo(g.x); v0[1] *= bfhi(g.x); v0[2] *= bflo(g.y); v0[3] *= bfhi(g.y);
                        v1[0] *= bflo(g.z); v1[1] *= bfhi(g.z); v1[2] *= bflo(g.w); v1[3] *= bfhi(g.w);
                    }
                    if (MODE == M_ADDMULG) {
                        const u32x4 g = ald[bj];
                        v0[0] += bflo(g.x); v0[1] += bfhi(g.x); v0[2] += bflo(g.y); v0[3] += bfhi(g.y);
                        v1[0] += bflo(g.z); v1[1] += bfhi(g.z); v1[2] += bflo(g.w); v1[3] += bfhi(g.w);
                    }
                    u32x4 w; w.x = pk2(v0[0], v0[1]); w.y = pk2(v0[2], v0[3]); w.z = pk2(v1[0], v1[1]); w.w = pk2(v1[2], v1[3]);
                    *(u32x4*)(rowp + bj * 128) = w;
                }
                if (MODE == M_GELUSQ) {
                    sqs += __shfl_xor(sqs, 16); sqs += __shfl_xor(sqs, 32);
                    if (fq == 0) sq[row * 16 + pnl * 4 + wc] = sqs;
                }
            }
        }
    }
    __device__ __forceinline__ void operator()(const f32x4 (&acc)[2][2][4][2], const pg8::Unit& u, int wr, int wc, int fr, int fq) const {
        const int pn = u.pn, s = (pn >= d->pb[1]) + (pn >= d->pb[2]) + (pn >= d->pb[3]);
        const int mode = d->m[s], ld = d->ld[s], pnl = pn - d->pb[s];
        bf16_t* base = (bf16_t*)(ws + d->o[s]);
        const bf16_t* aux = (const bf16_t*)(ws + d->aux);
        const int row0 = u.pm * 256 + wr * 64 + fr, col0 = pnl * 256 + wc * 32 + 8 * fq;
        switch (mode) {
            case M_NONE: run<M_NONE>(acc, base, aux, ld, row0, col0, pnl, wc, fq); break;
            case M_GELU: run<M_GELU>(acc, base, aux, ld, row0, col0, pnl, wc, fq); break;
            case M_GELUSQ: run<M_GELUSQ>(acc, base, aux, ld, row0, col0, pnl, wc, fq); break;
            case M_SIGMOID: run<M_SIGMOID>(acc, base, aux, ld, row0, col0, pnl, wc, fq); break;
            case M_SILU: run<M_SILU>(acc, base, aux, ld, row0, col0, pnl, wc, fq); break;
            case M_DT: run<M_DT>(acc, base, aux, ld, row0, col0, pnl, wc, fq); break;
            case M_MULG: run<M_MULG>(acc, base, aux, ld, row0, col0, pnl, wc, fq); break;
            default: run<M_ADDMULG>(acc, base, aux, ld, row0, col0, pnl, wc, fq); break;
        }
    }
};

__device__ __forceinline__ void cv_item(const float* W, int K, int N, int k0, int n0, bf16_t* WT, int dst_row0, LAS float* scr, int lane) {
    float wv[32];
#pragma unroll
    for (int i = 0; i < 32; ++i) wv[i] = W[(size_t)(k0 + 2 * i + (lane >> 5)) * N + n0 + (lane & 31)];
#pragma unroll
    for (int i = 0; i < 32; ++i) scr[(2 * i + (lane >> 5)) * 33 + (lane & 31)] = wv[i];
    asm volatile("s_waitcnt lgkmcnt(0)" ::: "memory");
    const int c = lane & 7;
#pragma unroll
    for (int j = 0; j < 4; ++j) { const int n = (lane >> 3) + 8 * j; const LAS float* s = scr + (8 * c) * 33 + n;
        u32x4 o; o.x = pk2(s[0 * 33], s[1 * 33]); o.y = pk2(s[2 * 33], s[3 * 33]); o.z = pk2(s[4 * 33], s[5 * 33]); o.w = pk2(s[6 * 33], s[7 * 33]);
        *(u32x4*)(WT + (size_t)(dst_row0 + n) * K + k0 + 8 * c) = o; }
    asm volatile("s_waitcnt lgkmcnt(0)" ::: "memory");
}
__device__ __forceinline__ void cv_job(const float* W, int K, int N, int c0, int ncols, bf16_t* WT, int r0, bool ileave, LAS float* scr, int& gw0, int NGW, int lane) {
    const int nnb = ncols / 32, nitems = (K / 64) * nnb;
    const int first = gw0; gw0 = (gw0 + NGW - nitems % NGW) % NGW;
    for (int it = first; it < nitems; it += NGW) {
        const int kb = it / nnb, nb = it - kb * nnb, c = 32 * nb;
        int dst = r0 + c;
        if (ileave) { dst = c < 2816 ? (256 * (c >> 7) + (c & 127)) : (256 * ((c - 2816) >> 7) + 128 + ((c - 2816) & 127)); }
        cv_item(W, K, N, 64 * kb, c0 + c, WT, dst, scr, lane);
    }
}

template <bool POST, bool PRE>
__device__ __forceinline__ void norm_rows(const float* xsrc, float* xdst, const bf16_t* O, const float* gpost, const float* gpre, bf16_t* H, int M, int gw, int NGW, int lane) {
#ifndef DBG_REPMASK
#pragma unroll 4
#endif
    for (int m = gw; m < M; m += NGW) {
        f32x4 v[4];
#pragma unroll
        for (int j = 0; j < 4; ++j) v[j] = ((const f32x4*)(xsrc + (size_t)m * DM))[lane + 64 * j];
        if (POST) {
            f32x4 y[4]; float ss = 0.f;
#pragma unroll
            for (int j = 0; j < 4; ++j) { const u32x2 o = ((const u32x2*)(O + (size_t)m * DM))[lane + 64 * j]; y[j][0] = bflo(o.x); y[j][1] = bfhi(o.x); y[j][2] = bflo(o.y); y[j][3] = bfhi(o.y);
                ss += (y[j][0] * y[j][0] + y[j][1] * y[j][1]) + (y[j][2] * y[j][2] + y[j][3] * y[j][3]); }
            const float r = rsqrtf(wave_sum(ss) * (1.f / DM) + EPS);
#pragma unroll
            for (int j = 0; j < 4; ++j) { const f32x4 g = ((const f32x4*)gpost)[lane + 64 * j]; v[j] += y[j] * r * g; ((f32x4*)(xdst + (size_t)m * DM))[lane + 64 * j] = v[j]; }
        }
        if (PRE) {
            float ss = 0.f;
#pragma unroll
            for (int j = 0; j < 4; ++j) ss += (v[j][0] * v[j][0] + v[j][1] * v[j][1]) + (v[j][2] * v[j][2] + v[j][3] * v[j][3]);
            const float r = rsqrtf(wave_sum(ss) * (1.f / DM) + EPS);
#pragma unroll
            for (int j = 0; j < 4; ++j) { const f32x4 g = ((const f32x4*)gpre)[lane + 64 * j]; const f32x4 o = v[j] * r * g; u32x2 w; w.x = pk2(o[0], o[1]); w.y = pk2(o[2], o[3]);
                ((u32x2*)(H + (size_t)m * DM))[lane + 64 * j] = w; }
        }
    }
}

template <int NCOL, bool SCALE>
__device__ __forceinline__ void load_conv_tile(LAS unsigned char* dst, int strideB, const bf16_t* raw, int ch0, bool first, const float* cw, const float* cb, const LAS float* wsc, int tid) {
    constexpr int CG = NCOL / 8, TR = 512 / CG, RUN = 128 / TR;
    const int cgi = tid % CG, tr = tid / CG, ch = ch0 + cgi * 8, s0 = tr * RUN;
    float w[4][8], bias[8];
#pragma unroll
    for (int k = 0; k < 4; ++k) { const f32x4 a = *(const f32x4*)(cw + k * 3072 + ch), b = *(const f32x4*)(cw + k * 3072 + ch + 4);
#pragma unroll
        for (int e = 0; e < 4; ++e) { w[k][e] = a[e]; w[k][4 + e] = b[e]; } }
    { const f32x4 a = *(const f32x4*)(cb + ch), b = *(const f32x4*)(cb + ch + 4);
#pragma unroll
        for (int e = 0; e < 4; ++e) { bias[e] = a[e]; bias[4 + e] = b[e]; } }
    u32x4 rows[RUN + 3];
#pragma unroll
    for (int r = 0; r < RUN + 3; ++r) { const int sr = s0 - 3 + r;
        rows[r] = (sr >= 0 || !first) ? *(const u32x4*)(raw + (long)sr * 3072 + ch) : (u32x4){0u, 0u, 0u, 0u}; }
#pragma unroll
    for (int i = 0; i < RUN; ++i) {
        float acc[8];
#pragma unroll
        for (int e = 0; e < 8; ++e) acc[e] = bias[e];
#pragma unroll
        for (int k = 0; k < 4; ++k) { const u32x4 v = rows[i + k];
            acc[0] += w[k][0] * bflo(v.x); acc[1] += w[k][1] * bfhi(v.x); acc[2] += w[k][2] * bflo(v.y); acc[3] += w[k][3] * bfhi(v.y);
            acc[4] += w[k][4] * bflo(v.z); acc[5] += w[k][5] * bfhi(v.z); acc[6] += w[k][6] * bflo(v.w); acc[7] += w[k][7] * bfhi(v.w); }
        float sc = 1.f;
        if (SCALE) sc = wsc[(cgi >> 3) * 128 + s0 + i];
#pragma unroll
        for (int e = 0; e < 8; ++e) acc[e] = silu_f(acc[e]) * sc;
        u32x4 o; o.x = pk2(acc[0], acc[1]); o.y = pk2(acc[2], acc[3]); o.z = pk2(acc[4], acc[5]); o.w = pk2(acc[6], acc[7]);
        *(LAS u32x4*)(dst + (s0 + i) * strideB + cgi * 16) = o;
    }
}
__device__ __forceinline__ void ssd_dt_scan(const float* dtbuf, int rowbase, int h, float a, int lane, float& d0, float& d1, float& c0, float& c1, float& total) {
    d0 = dtbuf[(size_t)(rowbase + 2 * lane) * 32 + h]; d1 = dtbuf[(size_t)(rowbase + 2 * lane + 1) * 32 + h];
    const float v0 = d0 * a, v1 = d1 * a; float x = v0 + v1;
#pragma unroll
    for (int o = 1; o < 64; o <<= 1) { const float y = __shfl_up(x, o); if (lane >= o) x += y; }
    c1 = x; c0 = x - v1; total = __shfl(x, 63);
}

constexpr int NPH_LAYER = 21, NPHASES = 1 + 2 * NPH_LAYER;


struct RmsXchg { unsigned* xbuf; unsigned* cnt; };
__device__ __forceinline__ void rms_exchange(const f32x4 (&v)[2][2][4][2], const pg8::Unit& u, int wr, int wc, int fr, int fq, LAS unsigned char* lds, int wid, int lane, const RmsXchg X) {
    LAS float* P = (LAS float*)lds;
    LAS float* S = (LAS float*)(lds + 4096);
#pragma unroll
    for (int ai = 0; ai < 2; ++ai)
#pragma unroll
        for (int m = 0; m < 4; ++m) {
            float s = 0.f;
#pragma unroll
            for (int bj = 0; bj < 2; ++bj)
#pragma unroll
                for (int n = 0; n < 2; ++n) { const f32x4 x = v[ai][bj][m][n]; s += (x[0] * x[0] + x[1] * x[1]) + (x[2] * x[2] + x[3] * x[3]); }
            s += __shfl_xor(s, 16); s += __shfl_xor(s, 32);
            if (fq == 0) P[(ai * 128 + wr * 64 + m * 16 + fr) * 4 + wc] = s;
        }
    asm volatile("s_waitcnt lgkmcnt(0)" ::: "memory"); __builtin_amdgcn_s_barrier(); asm volatile("" ::: "memory");
    const int row = wid * 32 + (lane & 31);
    if (lane < 32) {
        const float t = (P[row * 4 + 0] + P[row * 4 + 1]) + (P[row * 4 + 2] + P[row * 4 + 3]);
        __hip_atomic_store(X.xbuf + ((size_t)(u.pm * 256 + row)) * 4 + u.pn, __float_as_uint(t), __ATOMIC_RELAXED, __HIP_MEMORY_SCOPE_AGENT);
    }
    asm volatile("s_waitcnt vmcnt(0)" ::: "memory");
    if (lane == 0) __hip_atomic_fetch_add(X.cnt + 64 * u.pm, 1u, __ATOMIC_RELAXED, __HIP_MEMORY_SCOPE_AGENT);
    if (wid == 0) {
        unsigned spins = 0;
        while ((unsigned)__builtin_amdgcn_readfirstlane(__hip_atomic_load(X.cnt + 64 * u.pm, __ATOMIC_RELAXED, __HIP_MEMORY_SCOPE_AGENT)) < 32u && ++spins < (1u << 20)) __builtin_amdgcn_s_sleep(2);
        __builtin_amdgcn_fence(__ATOMIC_ACQUIRE, "agent");
    }
    asm volatile("s_waitcnt vmcnt(0) lgkmcnt(0)" ::: "memory"); __builtin_amdgcn_s_barrier(); asm volatile("" ::: "memory");
    if (lane < 32) {
        const unsigned* slot = X.xbuf + ((size_t)(u.pm * 256 + row)) * 4;
        float t = 0.f;
#pragma unroll
        for (int k = 0; k < 4; ++k) t += __uint_as_float(__hip_atomic_load(slot + k, __ATOMIC_RELAXED, __HIP_MEMORY_SCOPE_AGENT));
        S[row] = rsqrtf(t * (1.f / 1024.f) + EPS);
    }
    asm volatile("s_waitcnt lgkmcnt(0)" ::: "memory"); __builtin_amdgcn_s_barrier(); asm volatile("" ::: "memory");
}
struct EpiNorm {
    static constexpr bool PERM = false, AFTER_DRAIN = true;
    const float* xsrc; float* xdst; bf16_t* H; const float* gpost; const float* gpre; RmsXchg x1, x2; int pre;
    __device__ __forceinline__ void fused(f32x4 (&acc)[2][2][4][2], const pg8::Unit& u, int wr, int wc, int fr, int fq, LAS unsigned char* lds, int wid, int lane) const {
        const LAS float* S = (const LAS float*)(lds + 4096);
        LAS unsigned char* T = lds + 8192;
        const int tid = wid * 64 + lane;
        const int col0 = wc * 32 + 4 * fq;
        rms_exchange(acc, u, wr, wc, fr, fq, lds, wid, lane, x1);
        f32x4 gp[2][2];
#pragma unroll
        for (int bj = 0; bj < 2; ++bj)
#pragma unroll
            for (int n = 0; n < 2; ++n) gp[bj][n] = *(const f32x4*)(gpost + u.pn * 256 + col0 + bj * 128 + n * 16);
#pragma unroll
        for (int ai = 0; ai < 2; ++ai) {
            const size_t g0 = (size_t)(u.pm * 256 + ai * 128) * 1024 + u.pn * 256;
#pragma unroll
            for (int hb = 0; hb < 2; ++hb) {
                f32x4 t[8];
#pragma unroll
                for (int i = 0; i < 8; ++i) t[i] = *(const f32x4*)(xsrc + g0 + (size_t)((tid >> 6) + 8 * (8 * hb + i)) * 1024 + (tid & 63) * 4);
#pragma unroll
                for (int i = 0; i < 8; ++i) *(LAS f32x4*)(T + ((tid >> 6) + 8 * (8 * hb + i)) * 1040 + (tid & 63) * 16) = t[i];
            }
            asm volatile("s_waitcnt lgkmcnt(0)" ::: "memory"); __builtin_amdgcn_s_barrier(); asm volatile("" ::: "memory");
#pragma unroll
            for (int m = 0; m < 4; ++m) {
                const int r = wr * 64 + m * 16 + fr; const float sr = S[ai * 128 + r];
#pragma unroll
                for (int bj = 0; bj < 2; ++bj)
#pragma unroll
                    for (int n = 0; n < 2; ++n) { LAS f32x4* p = (LAS f32x4*)(T + r * 1040 + (col0 + bj * 128 + n * 16) * 4);
                        const f32x4 v = acc[ai][bj][m][n] * sr * gp[bj][n] + *p;
                        acc[ai][bj][m][n] = v; *p = v; }
            }
            asm volatile("s_waitcnt lgkmcnt(0)" ::: "memory"); __builtin_amdgcn_s_barrier(); asm volatile("" ::: "memory");
#pragma unroll
            for (int i = 0; i < 16; ++i) { const int row = (tid >> 6) + 8 * i;
                *(f32x4*)(xdst + g0 + (size_t)row * 1024 + (tid & 63) * 4) = *(const LAS f32x4*)(T + row * 1040 + (tid & 63) * 16); }
            asm volatile("s_waitcnt lgkmcnt(0)" ::: "memory"); __builtin_amdgcn_s_barrier(); asm volatile("" ::: "memory");
        }
        if (pre) {
            rms_exchange(acc, u, wr, wc, fr, fq, lds, wid, lane, x2);
#pragma unroll
            for (int bj = 0; bj < 2; ++bj)
#pragma unroll
                for (int n = 0; n < 2; ++n) gp[bj][n] = *(const f32x4*)(gpre + u.pn * 256 + col0 + bj * 128 + n * 16);
#pragma unroll
            for (int ai = 0; ai < 2; ++ai) {
                const size_t g0 = (size_t)(u.pm * 256 + ai * 128) * 1024 + u.pn * 256;
#pragma unroll
                for (int m = 0; m < 4; ++m) {
                    const int r = wr * 64 + m * 16 + fr; const float sr = S[ai * 128 + r];
#pragma unroll
                    for (int bj = 0; bj < 2; ++bj)
#pragma unroll
                        for (int n = 0; n < 2; ++n) { const f32x4 o = acc[ai][bj][m][n] * sr * gp[bj][n];
                            u32x2 w; w.x = pk2(o[0], o[1]); w.y = pk2(o[2], o[3]); *(LAS u32x2*)(T + r * 528 + (col0 + bj * 128 + n * 16) * 2) = w; }
                }
                asm volatile("s_waitcnt lgkmcnt(0)" ::: "memory"); __builtin_amdgcn_s_barrier(); asm volatile("" ::: "memory");
#pragma unroll
                for (int i = 0; i < 8; ++i) { const int row = (tid >> 5) + 16 * i;
                    *(u32x4*)(H + g0 + (size_t)row * 1024 + (tid & 31) * 8) = *(const LAS u32x4*)(T + row * 528 + (tid & 31) * 16); }
                asm volatile("s_waitcnt lgkmcnt(0)" ::: "memory"); __builtin_amdgcn_s_barrier(); asm volatile("" ::: "memory");
            }
        }
    }
};

#define BIGP (1 << 20)
#define GD_NONE {0, 0, 0, {0, 0, 0, 0}, {0, BIGP, BIGP, BIGP}, {0, 0, 0, 0}, {0, 0, 0, 0}, 0, 0, 0, 0}
#define GD_SIMPLE(A_, B_, O_, M_, N_, K_, MODE_, LD_, AUX_) {A_, B_, AUX_, {O_, O_, O_, O_}, {0, BIGP, BIGP, BIGP}, {MODE_, MODE_, MODE_, MODE_}, {LD_, LD_, LD_, LD_}, M_, N_, K_, 1}
__device__ const GD GDT[NPH_LAYER] = {
      {OFF_A(0), OFF_W, 0, {OFF_A(1), OFF_A(3), OFF_A(3), OFF_KV - (unsigned long long)T_TOK * 2048 * 2}, {0, 8, 20, 21}, {M_SILU, M_NONE, M_DT, M_NONE}, {2048, 3072, 3072, 2048}, T_TOK, 5376, 1024, 1},
      GD_NONE,   GD_NONE,   GD_NONE,
      {OFF_A(0), OFF_W, 0, {OFF_A(3), OFF_A(4), OFF_A(5), OFF_A(6)}, {0, 4, 8, 12}, {M_NONE, M_GELUSQ, M_SIGMOID, M_SIGMOID}, {1024, 1024, 1024, 1024}, T_TOK, 4096, 1024, 1},
      GD_NONE,
      GD_SIMPLE(OFF_A(1), OFF_W + 10 * MiB, OFF_A(6), T_TOK, 1024, 2048, M_MULG, 1024, 0),
      GD_SIMPLE(OFF_A(3), OFF_W + 8 * MiB, OFF_A(5), T_TOK, 1024, 1024, M_ADDMULG, 1024, OFF_A(6)),
      GD_SIMPLE(OFF_A(5), OFF_W + 14 * MiB, OFF_A(1), T_TOK, 1024, 1024, M_NONE, 1024, 0),
      GD_NONE,
      GD_SIMPLE(OFF_A(0), OFF_W, OFF_A(1), T_TOK, 1024, 1024, M_NONE, 1024, 0),
      GD_SIMPLE(OFF_A(2), OFF_W + 2 * MiB, OFF_A(3), 1024, 2048, 1024, M_NONE, 2048, 0),
      GD_NONE,
      GD_SIMPLE(OFF_A(4), OFF_W + 22 * MiB, OFF_A(1), T_TOK, 1024, 1024, M_NONE, 1024, 0),
      GD_NONE,
      GD_SIMPLE(OFF_A(0), OFF_W, OFF_A(1), T_TOK, 2816, 1024, M_NONE, 2816, 0),
      GD_NONE,
      GD_SIMPLE(OFF_A(0), OFF_W + 2816ull * 1024 * 2, OFF_A(1), T_TOK, 2816, 1024, M_NONE, 2816, 0),
      GD_NONE,
      GD_SIMPLE(OFF_A(4), OFF_W + 12 * MiB, OFF_A(1), T_TOK, 1024, 2816, M_NONE, 1024, 0),
      GD_NONE,
};

__global__ void __launch_bounds__(512, 2) fwd_megakernel(Args args) {
    extern __shared__ __attribute__((aligned(16))) unsigned char lds_raw[];
    LAS unsigned char* lds = (LAS unsigned char*)lds_raw;
    cg::grid_group grid = cg::this_grid();
    const int G = gridDim.x, NGW = G * 8;
    volatile LAS unsigned* xst = (volatile LAS unsigned*)(lds + LDS_MISC);
    if (threadIdx.x < 4) xst[threadIdx.x] = 0u;
    __syncthreads();
    XcdBarrier xbar = xcd_barrier_post((unsigned*)(args.ws + OFF_BAR), xst);

#ifdef DBG_REPMASK
    int redo = 0;
#endif
#pragma unroll 1
    for (int ph = args.lo; ph < args.hi; ++ph) {
        int tid = threadIdx.x; asm volatile("" : "+v"(tid));
        const int lane = tid & 63, wave = __builtin_amdgcn_readfirstlane(tid >> 6);
        const int gw = blockIdx.x * 8 + wave;
        LAS float* scr = (LAS float*)(lds + wave * 8448);
        int cvw = gw;
        typedef const __attribute__((address_space(4))) Args* ArgsP;
        ArgsP ap = (ArgsP)__builtin_amdgcn_kernarg_segment_ptr(); asm volatile("" : "+s"(ap));
        unsigned char* ws = ap->ws;
        bf16_t* WR = (bf16_t*)(ws + OFF_W);
        float* dtbuf = (float*)(ws + OFF_DT); float* vsq = (float*)(ws + OFF_VSQ); float* cdec = (float*)(ws + OFF_CDEC);
        bf16_t* Hb = (bf16_t*)(ws + OFF_A(0));
        const int l = ph == 0 ? 0 : (ph - 1) / NPH_LAYER;
        const int p = ph == 0 ? -1 : (ph - 1) % NPH_LAYER;

        const int pc = p < 0 ? 20 : p;
        if (p == 11) continue;
        if (p == 9 || p == 14 || p == 20) continue;
#ifdef DBG_REPMASK
        const bool ALT = ((DBG_REPMASK >> pc) & 1) && (DBG_REP_LMASK >> l & 1) && !redo && (pc == 1 || pc == 2 || pc == 3 || pc == 5);
#else
        constexpr bool ALT = false;
#endif
#ifdef DBG_SKIP
#define SKIP(b) (ALT && ((DBG_SKIP) & (b)))
#else
#define SKIP(b) false
#endif
        const bool gemm = p >= 0 && GDT[pc].isgemm != 0;
        if (p == 8 || p == 13 || p == 19) {
            const GD* d = &GDT[pc];
            const pg8::Gemm gd{(const bf16_t*)(ws + d->a), (const bf16_t*)(ws + d->b), d->M, d->N, d->K};
            const int site = l * 3 + (p == 8 ? 0 : (p == 13 ? 1 : 2));
            unsigned* xc = (unsigned*)(ws + OFF_XCNT); unsigned* xb = (unsigned*)(ws + OFF_XBUF);
            EpiNorm E;
            E.xsrc = (p == 8 && l == 0) ? ap->in[0] : (const float*)ap->out; E.xdst = ap->out; E.H = Hb;
            E.gpost = (p == 8 ? ap->in[3] : (p == 13 ? ap->in[6] : ap->in[8])) + l * DM;
            E.pre = !(p == 19 && l == 1);
            E.gpre = p == 8 ? ap->in[4] + l * DM : (p == 13 ? ap->in[7] + l * DM : ap->in[2] + DM);
            E.x1 = RmsXchg{xb + (size_t)(2 * site) * 65536, xc + (size_t)(2 * site) * 4096};
            E.x2 = RmsXchg{xb + (size_t)(2 * site + 1) * 65536, xc + (size_t)(2 * site + 1) * 4096};
            pg8::StaticOrder S; S.init(gd.M, gd.N, G, (int)blockIdx.x);
            pg8::gemm_phase<EpiNorm, pg8::StaticOrder>(lds, gd, S, E);
            __syncthreads();
            if (p == 8) {
                cv_job(ap->in[22] + (size_t)l * 1024 * 1024, 1024, 1024, 0, 1024, (bf16_t*)(ws + OFF_W), 0, false, scr, cvw, NGW, lane);
                cv_job(ap->in[24] + (size_t)l * 1024 * 1024, 1024, 1024, 0, 1024, (bf16_t*)(ws + OFF_W + 22 * MiB), 0, false, scr, cvw, NGW, lane);
            } else if (p == 13) {
                cv_job(ap->in[25] + (size_t)l * 1024 * 5632, 1024, 5632, 0, 5632, (bf16_t*)(ws + OFF_W), 0, true, scr, cvw, NGW, lane);
                cv_job(ap->in[28] + (size_t)l * 2816 * 1024, 2816, 1024, 0, 1024, (bf16_t*)(ws + OFF_W + 12 * MiB), 0, false, scr, cvw, NGW, lane);
            } else if (l == 0) {
                const int lw = 1;
                cv_job(ap->in[9] + (size_t)lw * 1024 * 9248, 1024, 9248, 2048, 5152, WR, 0, false, scr, cvw, NGW, lane);
                cv_job(ap->in[23] + (size_t)lw * 1024 * 2048, 1024, 2048, 0, 2048, (bf16_t*)(ws + OFF_WKV), 0, false, scr, cvw, NGW, lane);
                norm_rows<false, true>(ap->in[1], nullptr, nullptr, nullptr, ap->in[5] + lw * DM, (bf16_t*)(ws + OFF_MEMN), 1024, gw, NGW, lane);
                for (int i = blockIdx.x * 512 + tid; i < 28672; i += G * 512) ((u32x4*)(WR + (size_t)5152 * 1024))[i] = (u32x4){0u, 0u, 0u, 0u};
            }
        } else if (gemm) {
            const GD* d = &GDT[pc];
            const pg8::Gemm gd{(const bf16_t*)(ws + d->a), (const bf16_t*)(ws + d->b), d->M, d->N, d->K};
            EpiGen E; E.d = d; E.ws = ws; E.f32o = dtbuf; E.bias = ap->in[15] + l * 32; E.sq = vsq;
            pg8::StaticOrder S; S.init(gd.M, gd.N, G, (int)blockIdx.x);
            if (pc == 0) { S.nextra = 32; S.xm = 4; S.pm0 = 64; S.pn0 = 21; S.A2 = (const char*)(ws + OFF_MEMN); S.B2 = (const char*)(ws + OFF_WKV); }
            pg8::gemm_phase<EpiGen, pg8::StaticOrder>(lds, gd, S, E);
        } else if (p == -1) {
            if (p == -1) {
                norm_rows<false, true>(ap->in[0], nullptr, nullptr, nullptr, ap->in[2], Hb, T_TOK, gw, NGW, lane);
            }
            {
                const int lw = p == -1 ? 0 : 1;
                cv_job(ap->in[9] + (size_t)lw * 1024 * 9248, 1024, 9248, 2048, 5152, WR, 0, false, scr, cvw, NGW, lane);
                cv_job(ap->in[23] + (size_t)lw * 1024 * 2048, 1024, 2048, 0, 2048, (bf16_t*)(ws + OFF_WKV), 0, false, scr, cvw, NGW, lane);
                norm_rows<false, true>(ap->in[1], nullptr, nullptr, nullptr, ap->in[5] + lw * DM, (bf16_t*)(ws + OFF_MEMN), 1024, gw, NGW, lane);
                for (int i = blockIdx.x * 512 + tid; i < 28672; i += G * 512) ((u32x4*)(WR + (size_t)5152 * 1024))[i] = (u32x4){0u, 0u, 0u, 0u};
            }
        } else if (p == 1) {
            LAS float* wsc = (LAS float*)lds; LAS unsigned char* Bc = lds + 4096; LAS unsigned char* Xw = lds + 38912;
            const unsigned BcA = lds_addr(Bc), XwA = lds_addr(Xw);
            const bf16_t* XBC = (const bf16_t*)(ws + OFF_A(3)); bf16_t* states = (bf16_t*)(ws + OFF_A(6));
            const float* cw = ap->in[13] + (size_t)l * 4 * 3072; const float* cb = ap->in[14] + (size_t)l * 3072;
            for (int u = blockIdx.x; u < 512; u += G) {
                int tl_ = tid; asm volatile("" : "+v"(tl_)); const int tid = tl_, lane = tl_ & 63;
                const int g = u & 3, bc = u >> 2, rowbase = bc * 128; const bool first = (bc & 31) == 0;
                { const int h = g * 8 + wave; const float a = -__expf(ap->in[16][l * 32 + h]); float d0, d1, c0, c1, tot;
                  ssd_dt_scan(dtbuf, rowbase, h, a, lane, d0, d1, c0, c1, tot);
                  wsc[wave * 128 + 2 * lane] = __expf(tot - c0) * d0; wsc[wave * 128 + 2 * lane + 1] = __expf(tot - c1) * d1;
                  if (lane == 0) cdec[bc * 32 + h] = __expf(tot); }
                const bf16_t* raw = XBC + (size_t)rowbase * 3072;
                load_conv_tile<128, false>(Bc, 272, raw, 2048 + g * 128, first, cw, cb, nullptr, tid);
                __syncthreads();
#pragma unroll 1
                for (int quad = 0; quad < 2; ++quad) {
                    if (!SKIP(32)) load_conv_tile<256, true>(Xw, 528, raw, g * 512 + quad * 256, first, cw, cb, wsc + quad * 512, tid);
                    __syncthreads();
                    const int hl = wave >> 1, nh = wave & 1;
                    if (!SKIP(64)) {
                    f32x4 acc[4][4];
#pragma unroll
                    for (int i = 0; i < 4; ++i)
#pragma unroll
                        for (int j = 0; j < 4; ++j) acc[i][j] = (f32x4){0.f, 0.f, 0.f, 0.f};
#pragma unroll 1
                    for (int ks = 0; ks < 4; ++ks) {
                        bf16x8 A[4], B[4];
                        frag_tr_x4<true>(BcA, 272, 32 * ks, 64 * nh, 16, lane, 8, 4, A); frag_tr_x4(XwA, 528, 32 * ks, 64 * hl, 16, lane, 8, 4, B);
#pragma unroll
                        for (int i = 0; i < 4; ++i)
#pragma unroll
                            for (int j = 0; j < 4; ++j) acc[i][j] = mfma16(A[i], B[j], acc[i][j]);
                    }
                    const int h = g * 8 + quad * 4 + hl; bf16_t* Sp = states + ((size_t)(bc * 32 + h) << 13);
#pragma unroll
                    for (int i = 0; i < 4; ++i)
#pragma unroll
                        for (int j = 0; j < 4; ++j) { const int pp = 16 * j + (lane & 15), n = 64 * nh + PPERM(i) + 8 * (lane >> 4);
                            u32x2 w; w.x = pk2(acc[i][j][0], acc[i][j][1]); w.y = pk2(acc[i][j][2], acc[i][j][3]); if (!SKIP(256)) *(u32x2*)(Sp + pp * 128 + n) = w; else if (w.x == 0x12345678u) cdec[0] = 1.f; }
                    }
                    __syncthreads();
                }
            }
        } else if (p == 2) {
            bf16_t* states = (bf16_t*)(ws + OFF_A(6)); bf16_t* sout = ALT ? (bf16_t*)ap->out : states;
            for (int i = blockIdx.x * 512 + tid; i < 131072; i += G * 512) {
                const int e8 = i & 1023, h = (i >> 10) & 31, b = i >> 15;
                float f[8];
#pragma unroll
                for (int e = 0; e < 8; ++e) f[e] = 0.f;
#pragma unroll 1
                for (int c0 = 0; c0 < 32; c0 += 16) {
                    u32x4 stv[16]; float decv[16];
#pragma unroll
                    for (int k = 0; k < 16; ++k) { stv[k] = *(const u32x4*)(states + ((size_t)((b * 32 + c0 + k) * 32 + h) << 13) + e8 * 8); decv[k] = cdec[(b * 32 + c0 + k) * 32 + h]; }
#pragma unroll
                    for (int k = 0; k < 16; ++k) {
                        const u32x4 st = stv[k]; const float dec = decv[k];
                        u32x4 o; o.x = pk2(f[0], f[1]); o.y = pk2(f[2], f[3]); o.z = pk2(f[4], f[5]); o.w = pk2(f[6], f[7]);
                        *(u32x4*)(sout + ((size_t)((b * 32 + c0 + k) * 32 + h) << 13) + e8 * 8) = o;
                        f[0] = f[0] * dec + bflo(st.x); f[1] = f[1] * dec + bfhi(st.x); f[2] = f[2] * dec + bflo(st.y); f[3] = f[3] * dec + bfhi(st.y);
                        f[4] = f[4] * dec + bflo(st.z); f[5] = f[5] * dec + bfhi(st.z); f[6] = f[6] * dec + bflo(st.w); f[7] = f[7] * dec + bfhi(st.w);
                    }
                }
            }
            const float* Win = ap->in[9] + (size_t)l * 1024 * 9248;
            cv_job(Win, 1024, 9248, 0, 2048, WR, 0, false, scr, cvw, NGW, lane);
            cv_job(Win, 1024, 9248, 7200, 2048, WR, 2048, false, scr, cvw, NGW, lane);
            cv_job(ap->in[19] + (size_t)l * 1024 * 1024, 1024, 1024, 0, 1024, (bf16_t*)(ws + OFF_W + 8 * MiB), 0, false, scr, cvw, NGW, lane);
            cv_job(ap->in[20] + (size_t)l * 2048 * 1024, 2048, 1024, 0, 1024, (bf16_t*)(ws + OFF_W + 10 * MiB), 0, false, scr, cvw, NGW, lane);
            cv_job(ap->in[21] + (size_t)l * 1024 * 1024, 1024, 1024, 0, 1024, (bf16_t*)(ws + OFF_W + 14 * MiB), 0, false, scr, cvw, NGW, lane);
        } else if (p == 3) {
            LAS float* acs = (LAS float*)lds; LAS float* dtv = (LAS float*)(lds + 4096); LAS float* rsq = (LAS float*)(lds + 8192);
            LAS unsigned char* Cc = lds + 12288; LAS unsigned char* Sc = lds + 47104; LAS unsigned char* Xt = lds + 81920;
            const unsigned XtA = lds_addr(Xt);
            const bf16_t* XBC = (const bf16_t*)(ws + OFF_A(3)); const bf16_t* states = (const bf16_t*)(ws + OFF_A(6)); bf16_t* Y = ALT ? (bf16_t*)ap->out : (bf16_t*)(ws + OFF_A(1)); const bf16_t* Zin = (const bf16_t*)(ws + OFF_A(1));
            const float* cw = ap->in[13] + (size_t)l * 4 * 3072; const float* cb = ap->in[14] + (size_t)l * 3072;
            const float* ng = ap->in[18] + (size_t)l * 2048;
            for (int u = blockIdx.x; u < 512; u += G) {
                int tl_ = tid; asm volatile("" : "+v"(tl_)); const int tid = tl_, lane = tl_ & 63;
                const int g = u & 3, bc = u >> 2, rowbase = bc * 128; const bool first = (bc & 31) == 0;
                { const int h = g * 8 + wave; const float a = -__expf(ap->in[16][l * 32 + h]); float d0, d1, c0, c1, tot;
                  ssd_dt_scan(dtbuf, rowbase, h, a, lane, d0, d1, c0, c1, tot);
                  acs[wave * 128 + 2 * lane] = c0; acs[wave * 128 + 2 * lane + 1] = c1; dtv[wave * 128 + 2 * lane] = d0; dtv[wave * 128 + 2 * lane + 1] = d1; }
                const bf16_t* raw = XBC + (size_t)rowbase * 3072;
                if (!SKIP(16)) {
                load_conv_tile<128, false>(Cc, 272, raw, 2560 + g * 128, first, cw, cb, nullptr, tid);
                load_conv_tile<128, false>(Xt, 272, raw, 2048 + g * 128, first, cw, cb, nullptr, tid);
                }
                __syncthreads();
                {
                    const int jt = wave;
                    for (int it = 0; it <= jt; ++it) {
                        f32x4 acc = (f32x4){0.f, 0.f, 0.f, 0.f};
#pragma unroll
                        for (int ks = 0; ks < 4; ++ks) acc = mfma16(frag_row(Xt, 272, 16 * it, 32 * ks, lane), frag_row(Cc, 272, 16 * jt, 32 * ks, lane), acc);
                        u32x2 w; w.x = pk2(acc[0], acc[1]); w.y = pk2(acc[2], acc[3]);
                        *(LAS u32x2*)(Sc + (16 * jt + (lane & 15)) * 272 + (16 * it + 4 * (lane >> 4)) * 2) = w;
                    }
                }
                __syncthreads();
                const int hl = wave & 3, lh = wave >> 2;
                u32x2 keep[2][4][4];
#pragma unroll
                for (int quad = 0; quad < 2; ++quad) {
                    const int hh8 = quad * 4 + hl, h = g * 8 + hh8;
                    const bf16_t* prevp = states + ((size_t)(bc * 32 + h) << 13);
                    if (!SKIP(4)) load_conv_tile<256, false>(Xt, 528, raw, g * 512 + quad * 256, first, cw, cb, nullptr, tid);
#if 0
                    bf16x8 PA[2][4];
#pragma unroll
                    for (int ks = 0; ks < 2; ++ks)
#pragma unroll
                        for (int i = 0; i < 4; ++i) PA[ks][i] = *(const bf16x8*)(prevp + (PPERM(i) + 8 * ((lane & 15) >> 2) + (lane & 3)) * 128 + 32 * ks + 8 * (lane >> 4));
#define PAF(ks, i) PA[(ks) & 1][i]
#else
#define PAF(ks, i) (*(const bf16x8*)(prevp + (PPERM(i) + 8 * ((lane & 15) >> 2) + (lane & 3)) * 128 + 32 * (ks) + 8 * (lane >> 4)))
#endif
                    __syncthreads();
                    f32x4 acc[4][4];
#pragma unroll
                    for (int i = 0; i < 4; ++i)
#pragma unroll
                        for (int j = 0; j < 4; ++j) acc[i][j] = (f32x4){0.f, 0.f, 0.f, 0.f};
#if 0
                    bf16x8 PB[2][4];
#pragma unroll
                    for (int ks = 0; ks < 2; ++ks)
#pragma unroll
                        for (int i = 0; i < 4; ++i) PB[ks][i] = *(const bf16x8*)(prevp + (PPERM(i) + 8 * ((lane & 15) >> 2) + (lane & 3)) * 128 + 32 * (ks + 2) + 8 * (lane >> 4));
#define PBF(ks, i) PB[(ks) & 1][i]
#else
#define PBF(ks, i) (*(const bf16x8*)(prevp + (PPERM(i) + 8 * ((lane & 15) >> 2) + (lane & 3)) * 128 + 32 * (ks) + 8 * (lane >> 4)))
#endif
#pragma unroll 1
                    for (int ks = 0; ks < (SKIP(2) ? 0 : 4); ++ks) {
                        bf16x8 B[4];
#pragma unroll
                        for (int i = 0; i < 4; ++i) B[i] = frag_row(Cc, 272, 64 * lh + 16 * i, 32 * ks, lane);
#pragma unroll
                        for (int i = 0; i < 4; ++i)
#pragma unroll
                            for (int j = 0; j < 4; ++j) acc[i][j] = mfma16(ks < 2 ? PAF(ks, i) : PBF(ks, i), B[j], acc[i][j]);
                    }
#pragma unroll
                    for (int j = 0; j < 4; ++j) { const float e = __expf(acs[hh8 * 128 + 64 * lh + 16 * j + (lane & 15)]);
#pragma unroll
                        for (int i = 0; i < 4; ++i) acc[i][j] *= e; }
#pragma unroll 1
#ifdef DBG_NO_YDIAG
#define DBG_KDIAG -1
#else
#define DBG_KDIAG (2 * lh + 1)
#endif
                    for (int ks = 0; ks <= (SKIP(1) ? -1 : DBG_KDIAG); ++ks) {
                        bf16x8 A[4];
                        frag_tr_x4<true>(XtA, 528, 32 * ks, 64 * hl, 16, lane, 8, 4, A);
#pragma unroll
                        for (int j = 0; j < 4; ++j) {
                            const int l0 = 64 * lh + 16 * j;
                            if (32 * ks > l0 + 15) continue;
                            const bf16x8 scv = frag_row(Sc, 272, l0, 32 * ks, lane);
                            const u32x4 scu = __builtin_bit_cast(u32x4, scv);
                            const int li = l0 + (lane & 15), sb = 32 * ks + 8 * (lane >> 4);
                            const float al = acs[hh8 * 128 + li];
                            const f32x4 as0 = *(const LAS f32x4*)(acs + hh8 * 128 + sb), as1 = *(const LAS f32x4*)(acs + hh8 * 128 + sb + 4);
                            const f32x4 dd0 = *(const LAS f32x4*)(dtv + hh8 * 128 + sb), dd1 = *(const LAS f32x4*)(dtv + hh8 * 128 + sb + 4);
                            float f[8];
                            f[0] = bflo(scu.x); f[1] = bfhi(scu.x); f[2] = bflo(scu.y); f[3] = bfhi(scu.y); f[4] = bflo(scu.z); f[5] = bfhi(scu.z); f[6] = bflo(scu.w); f[7] = bfhi(scu.w);
#pragma unroll
                            for (int e = 0; e < 4; ++e) {
                                f[e] = (sb + e <= li) ? f[e] : 0.f; f[4 + e] = (sb + 4 + e <= li) ? f[4 + e] : 0.f;
                                f[e] *= __expf(fminf(al - as0[e], 0.f)) * dd0[e]; f[4 + e] *= __expf(fminf(al - as1[e], 0.f)) * dd1[e];
                            }
                            u32x4 bm; bm.x = pk2(f[0], f[1]); bm.y = pk2(f[2], f[3]); bm.z = pk2(f[4], f[5]); bm.w = pk2(f[6], f[7]);
                            const bf16x8 Bm = __builtin_bit_cast(bf16x8, bm);
#pragma unroll
                            for (int i = 0; i < 4; ++i) acc[i][j] = mfma16(A[i], Bm, acc[i][j]);
                        }
                    }
                    const float Dh = ap->in[17][l * 32 + h];
                    if (!SKIP(8)) {
                    u32x2 zall[4][4];
#pragma unroll
                    for (int j = 0; j < 4; ++j)
#pragma unroll
                        for (int i = 0; i < 4; ++i) zall[j][i] = *(const u32x2*)(Zin + (size_t)(rowbase + 64 * lh + 16 * j + (lane & 15)) * 2048 + h * 64 + PPERM(i) + 8 * (lane >> 4));
#pragma unroll
                    for (int j = 0; j < 4; ++j) {
                        const int li = 64 * lh + 16 * j + (lane & 15); float ssq = 0.f;
#pragma unroll
                        for (int i = 0; i < 4; ++i) {
                            const int pp = PPERM(i) + 8 * (lane >> 4);
                            const u32x2 xv = *(const LAS u32x2*)(Xt + li * 528 + (64 * hl + pp) * 2);
                            u32x2* zp = (u32x2*)(Y + (size_t)(rowbase + li) * 2048 + h * 64 + pp); const u32x2 zv = zall[j][i];
                            const float v0 = (acc[i][j][0] + Dh * bflo(xv.x)) * bflo(zv.x), v1 = (acc[i][j][1] + Dh * bfhi(xv.x)) * bfhi(zv.x);
                            const float v2 = (acc[i][j][2] + Dh * bflo(xv.y)) * bflo(zv.y), v3 = (acc[i][j][3] + Dh * bfhi(xv.y)) * bfhi(zv.y);
                            ssq += (v0 * v0 + v1 * v1) + (v2 * v2 + v3 * v3);
                            u32x2 w; w.x = pk2(v0, v1); w.y = pk2(v2, v3); keep[quad][j][i] = w; (void)zp;
                        }
                        ssq += __shfl_xor(ssq, 16); ssq += __shfl_xor(ssq, 32);
                        if ((lane >> 4) == 0) rsq[hh8 * 128 + li] = ssq;
                    }
                    }
                    __syncthreads();
                }
#ifndef DBG_NOFIX
#define DBG_FIXQ 2
#else
#define DBG_FIXQ 0
#endif
#pragma unroll
                for (int quad = 0; quad < 2; ++quad) {
                    if (SKIP(8)) continue;
                    const int h = g * 8 + quad * 4 + hl;
#pragma unroll
                    for (int j = 0; j < 4; ++j) {
                        const int li = 64 * lh + 16 * j + (lane & 15); float s = 0.f;
#pragma unroll
                        for (int k = 0; k < 8; ++k) s += rsq[k * 128 + li];
                        const float r = rsqrtf(s * (1.f / 512.f) + EPS);
#pragma unroll
                        for (int i = 0; i < 4; ++i) {
                            const int pp = PPERM(i) + 8 * (lane >> 4);
                            const u32x2 zv = keep[quad][j][i];
                            const f32x4 gn = *(const f32x4*)(ng + h * 64 + pp);
                            u32x2 w; w.x = pk2(bflo(zv.x) * r * gn[0], bfhi(zv.x) * r * gn[1]); w.y = pk2(bflo(zv.y) * r * gn[2], bfhi(zv.y) * r * gn[3]);
                            *(LAS u32x2*)(Cc + li * 1040 + ((quad * 4 + hl) * 64 + pp) * 2) = w;
                        }
                    }
                }
                __syncthreads();
#pragma unroll
                for (int i = 0; i < 16; ++i) { const int row = (tid >> 6) + 8 * i;
                    *(u32x4*)(Y + (size_t)(rowbase + row) * 2048 + g * 512 + (tid & 63) * 8) = *(const LAS u32x4*)(Cc + row * 1040 + (tid & 63) * 16); }
                __syncthreads();
            }
        } else if (p == 5) {
            LAS unsigned char* Wt = lds; LAS unsigned char* Vt = lds + 34816; LAS float* rs = (LAS float*)(lds + 69632);
            const unsigned VtA = lds_addr(Vt);
            const float* Wsp = ap->in[11] + (size_t)l * 8 * 128 * 128; const float* bs = ap->in[12] + (size_t)l * 8 * 128; const float* gain = ap->in[10] + (size_t)l * 1024;
            bf16_t* Ug = ALT ? (bf16_t*)ap->out : (bf16_t*)(ws + OFF_A(3)); const bf16_t* Uin = (const bf16_t*)(ws + OFF_A(3)); const bf16_t* Vg = (const bf16_t*)(ws + OFF_A(4));
            for (int u = blockIdx.x; u < 1024; u += G) {
                int tl_ = tid; asm volatile("" : "+v"(tl_)); const int tid = tl_, lane = tl_ & 63;
                const int g = u & 7, bc = u >> 3, rowbase = bc * 128;
                f32x4 wreg[8]; u32x4 vreg[4];
#pragma unroll
                for (int i = 0; i < 8; ++i) { const int idx = tid + 512 * i, t = idx >> 5, s4 = (idx & 31) * 4; wreg[i] = *(const f32x4*)(Wsp + (size_t)(g * 128 + t) * 128 + s4); }
#pragma unroll
                for (int i = 0; i < 4; ++i) { const int idx = tid + 512 * i, s = idx >> 4, c8 = (idx & 15) * 8; vreg[i] = *(const u32x4*)(Vg + (size_t)(rowbase + s) * 1024 + g * 128 + c8); }
                if (tid < 128) { const f32x4* pp = (const f32x4*)(vsq + (size_t)(rowbase + tid) * 16); const f32x4 a = pp[0], b = pp[1], c = pp[2], d = pp[3];
                    const float s = ((a[0] + a[1]) + (a[2] + a[3])) + ((b[0] + b[1]) + (b[2] + b[3])) + ((c[0] + c[1]) + (c[2] + c[3])) + ((d[0] + d[1]) + (d[2] + d[3]));
                    rs[tid] = rsqrtf(s * (1.f / 1024.f) + EPS); }
                __syncthreads();
#pragma unroll
                for (int i = 0; i < 8; ++i) { const int idx = tid + 512 * i, t = idx >> 5, s4 = (idx & 31) * 4;
                    f32x4 w = wreg[i]; const f32x4 r4 = *(const LAS f32x4*)(rs + s4);
#pragma unroll
                    for (int e = 0; e < 4; ++e) w[e] = (s4 + e <= t) ? w[e] * r4[e] : 0.f;
                    u32x2 o; o.x = pk2(w[0], w[1]); o.y = pk2(w[2], w[3]); *(LAS u32x2*)(Wt + t * 272 + s4 * 2) = o; }
#pragma unroll
                for (int i = 0; i < 4; ++i) { const int idx = tid + 512 * i, s = idx >> 4, c8 = (idx & 15) * 8; *(LAS u32x4*)(Vt + s * 272 + c8 * 2) = vreg[i]; }
                __syncthreads();
                const int t0 = 16 * wave, nks = (t0 + 15) / 32 + 1;
                u32x2 uall[8];
#pragma unroll
                for (int i = 0; i < 8; ++i) uall[i] = *(const u32x2*)(Uin + (size_t)(rowbase + t0 + (lane & 15)) * 1024 + g * 128 + 16 * i + 4 * (lane >> 4));
                f32x4 acc[8];
#pragma unroll
                for (int i = 0; i < 8; ++i) acc[i] = (f32x4){0.f, 0.f, 0.f, 0.f};
#pragma unroll 1
                for (int ks = 0; ks < nks; ++ks) {
                    const bf16x8 b = frag_row(Wt, 272, t0, 32 * ks, lane);
                    bf16x8 va[4], vb[4];
                    frag_tr_x4(VtA, 272, 32 * ks, 0, 16, lane, 8, 4, va); frag_tr_x4(VtA, 272, 32 * ks, 64, 16, lane, 8, 4, vb);
#pragma unroll
                    for (int i = 0; i < 4; ++i) { acc[i] = mfma16(va[i], b, acc[i]); acc[4 + i] = mfma16(vb[i], b, acc[4 + i]); }
                }
                const int t = t0 + (lane & 15); const float bsv = bs[g * 128 + t];
#pragma unroll
                for (int i = 0; i < 8; ++i) { const int d = 16 * i + 4 * (lane >> 4); const f32x4 gn = *(const f32x4*)(gain + g * 128 + d);
                    u32x2* up = (u32x2*)(Ug + (size_t)(rowbase + t) * 1024 + g * 128 + d); const u32x2 uv = uall[i];
                    u32x2 o; o.x = pk2((acc[i][0] * gn[0] + bsv) * gelu_f(bflo(uv.x)), (acc[i][1] * gn[1] + bsv) * gelu_f(bfhi(uv.x)));
                    o.y = pk2((acc[i][2] * gn[2] + bsv) * gelu_f(bflo(uv.y)), (acc[i][3] * gn[3] + bsv) * gelu_f(bfhi(uv.y))); *up = o; }
                __syncthreads();
            }
        } else if (p == 12) {
            const unsigned LA = lds_addr(lds);
            const bf16_t* Q = (const bf16_t*)(ws + OFF_A(1)); const bf16_t* KV = (const bf16_t*)(ws + OFF_KV); bf16_t* O2 = (bf16_t*)(ws + OFF_A(4));
            for (int u = blockIdx.x; u < 256; u += G) {
                int tl_ = tid; asm volatile("" : "+v"(tl_)); const int tid = tl_, lane = tl_ & 63;
                const int qb = u & 15, h = (u >> 4) & 3, b = u >> 6;
                const bf16_t* Kg = KV + (size_t)(b * 256) * 2048 + h * 256;
#pragma unroll
                for (int i = 0; i < 16; ++i) { const int idx = tid + 512 * i, m = idx >> 5, c8 = (idx & 31) * 8; *(LAS u32x4*)(lds + m * 528 + c8 * 2) = *(const u32x4*)(Kg + (size_t)m * 2048 + c8); }
                const int q0 = b * 4096 + qb * 256 + 32 * wave;
                const bf16_t* Qp = Q + (size_t)(q0 + (lane & 15)) * 1024 + h * 256 + 8 * (lane >> 4);
                __syncthreads();
                f32x4 s[2][16];
#pragma unroll
                for (int t = 0; t < 2; ++t)
#pragma unroll
                    for (int mt = 0; mt < 16; ++mt) s[t][mt] = (f32x4){0.f, 0.f, 0.f, 0.f};
#pragma unroll 2
                for (int ks = 0; ks < 8; ++ks) {
                    const bf16x8 q0f = *(const bf16x8*)(Qp + 32 * ks), q1f = *(const bf16x8*)(Qp + 16 * 1024 + 32 * ks);
#pragma unroll
                    for (int mt = 0; mt < 16; ++mt) { const bf16x8 a = frag_row(lds, 528, 16 * mt, 32 * ks, lane); s[0][mt] = mfma16(a, q0f, s[0][mt]); s[1][mt] = mfma16(a, q1f, s[1][mt]); }
                }
                bf16x8 pb[2][8];
#pragma unroll
                for (int t = 0; t < 2; ++t) {
                    float mx = -3.0e38f;
#pragma unroll
                    for (int mt = 0; mt < 16; ++mt) mx = fmaxf(mx, fmaxf(fmaxf(s[t][mt][0], s[t][mt][1]), fmaxf(s[t][mt][2], s[t][mt][3])));
                    mx = fmaxf(mx, __shfl_xor(mx, 16)); mx = fmaxf(mx, __shfl_xor(mx, 32));
                    const float cs = 0.0625f * 1.44269504089f; float sum = 0.f;
#pragma unroll
                    for (int mt = 0; mt < 16; ++mt)
#pragma unroll
                        for (int e = 0; e < 4; ++e) { s[t][mt][e] = exp2f((s[t][mt][e] - mx) * cs); sum += s[t][mt][e]; }
                    sum += __shfl_xor(sum, 16); sum += __shfl_xor(sum, 32);
                    const float inv = __fdividef(1.f, sum);
#pragma unroll
                    for (int kb = 0; kb < 8; ++kb) { u32x4 w; w.x = pk2(s[t][2 * kb][0] * inv, s[t][2 * kb][1] * inv); w.y = pk2(s[t][2 * kb][2] * inv, s[t][2 * kb][3] * inv);
                        w.z = pk2(s[t][2 * kb + 1][0] * inv, s[t][2 * kb + 1][1] * inv); w.w = pk2(s[t][2 * kb + 1][2] * inv, s[t][2 * kb + 1][3] * inv); pb[t][kb] = __builtin_bit_cast(bf16x8, w); }
                }
                __syncthreads();
#pragma unroll
                for (int i = 0; i < 16; ++i) { const int idx = tid + 512 * i, m = idx >> 5, c8 = (idx & 31) * 8; *(LAS u32x4*)(lds + m * 528 + c8 * 2) = *(const u32x4*)(Kg + 1024 + (size_t)m * 2048 + c8); }
                __syncthreads();
#pragma unroll 1
                for (int dh = 0; dh < 2; ++dh) {
                    f32x4 o[2][8];
#pragma unroll
                    for (int t = 0; t < 2; ++t)
#pragma unroll
                        for (int i = 0; i < 8; ++i) o[t][i] = (f32x4){0.f, 0.f, 0.f, 0.f};
#pragma unroll
                    for (int kb = 0; kb < 8; ++kb) {
#pragma unroll
                        for (int d4 = 0; d4 < 2; ++d4) { bf16x8 vf[4]; frag_tr_x4(LA, 528, 32 * kb, 128 * dh + 64 * d4, 16, lane, 4, 16, vf);
#pragma unroll
                            for (int i = 0; i < 4; ++i) { o[0][4 * d4 + i] = mfma16(vf[i], pb[0][kb], o[0][4 * d4 + i]); o[1][4 * d4 + i] = mfma16(vf[i], pb[1][kb], o[1][4 * d4 + i]); } }
                    }
#pragma unroll
                    for (int t = 0; t < 2; ++t)
#pragma unroll
                        for (int i = 0; i < 8; ++i) { u32x2 w; w.x = pk2(o[t][i][0], o[t][i][1]); w.y = pk2(o[t][i][2], o[t][i][3]);
                            *(u32x2*)(O2 + (size_t)(q0 + 16 * t + (lane & 15)) * 1024 + h * 256 + 128 * dh + 16 * i + 4 * (lane >> 4)) = w; }
                }
                __syncthreads();
            }
        } else if (p == 16 || p == 18) {
            const int hh = p == 18 ? 1 : 0;
            const bf16_t* UP = (const bf16_t*)(ws + OFF_A(1)); bf16_t* Gb = (bf16_t*)(ws + OFF_A(4));
            const float* cw = ap->in[26] + (size_t)l * 3 * 5632; const float* cb = ap->in[27] + (size_t)l * 5632;
            for (int u = blockIdx.x; u < 11 * 64; u += G) {
                int tl_ = tid; asm volatile("" : "+v"(tl_)); const int tid = tl_, lane = tl_ & 63;
                const int jj = u % 11, tb = u / 11, cgi = tid & 15, tr = tid >> 4, t0 = tb * 256 + tr * 8, j = 11 * hh + jj;
                const int ca = 128 * j + 8 * cgi, cbb = 2816 + ca;
                float wa[3][8], wb[3][8], ba[8], bb[8];
#pragma unroll
                for (int k = 0; k < 3; ++k) { const f32x4 a0 = *(const f32x4*)(cw + k * 5632 + ca), a1 = *(const f32x4*)(cw + k * 5632 + ca + 4), b0 = *(const f32x4*)(cw + k * 5632 + cbb), b1 = *(const f32x4*)(cw + k * 5632 + cbb + 4);
#pragma unroll
                    for (int e = 0; e < 4; ++e) { wa[k][e] = a0[e]; wa[k][4 + e] = a1[e]; wb[k][e] = b0[e]; wb[k][4 + e] = b1[e]; } }
                { const f32x4 a0 = *(const f32x4*)(cb + ca), a1 = *(const f32x4*)(cb + ca + 4), b0 = *(const f32x4*)(cb + cbb), b1 = *(const f32x4*)(cb + cbb + 4);
#pragma unroll
                    for (int e = 0; e < 4; ++e) { ba[e] = a0[e]; ba[4 + e] = a1[e]; bb[e] = b0[e]; bb[4 + e] = b1[e]; } }
                const bf16_t* base = UP + (size_t)t0 * 2816 + 256 * jj + 8 * cgi;
                const bool seq0 = (t0 & 4095) == 0;
                u32x4 a2 = (u32x4){0u, 0u, 0u, 0u}, a1 = a2, b2 = a2, b1 = a2;
                if (!seq0) { a2 = *(const u32x4*)(base - 2 * 2816); a1 = *(const u32x4*)(base - 2816); b2 = *(const u32x4*)(base - 2 * 2816 + 128); b1 = *(const u32x4*)(base - 2816 + 128); }
                u32x4 arow[8], brow[8];
#pragma unroll
                for (int i = 0; i < 8; ++i) { arow[i] = *(const u32x4*)(base + (size_t)i * 2816); brow[i] = *(const u32x4*)(base + (size_t)i * 2816 + 128); }
#pragma unroll
                for (int i = 0; i < 8; ++i) {
                    const u32x4 a0 = arow[i], b0 = brow[i];
                    float ga[8], gb[8];
#define UNP(dst, k, src) dst[0] += k[0] * bflo(src.x); dst[1] += k[1] * bfhi(src.x); dst[2] += k[2] * bflo(src.y); dst[3] += k[3] * bfhi(src.y); dst[4] += k[4] * bflo(src.z); dst[5] += k[5] * bfhi(src.z); dst[6] += k[6] * bflo(src.w); dst[7] += k[7] * bfhi(src.w);
#pragma unroll
                    for (int e = 0; e < 8; ++e) { ga[e] = ba[e]; gb[e] = bb[e]; }
                    UNP(ga, wa[0], a2) UNP(ga, wa[1], a1) UNP(ga, wa[2], a0)
                    UNP(gb, wb[0], b2) UNP(gb, wb[1], b1) UNP(gb, wb[2], b0)
#undef UNP
                    float r[8];
#pragma unroll
                    for (int e = 0; e < 8; ++e) r[e] = gelu_f(ga[e]) * gb[e];
                    u32x4 o; o.x = pk2(r[0], r[1]); o.y = pk2(r[2], r[3]); o.z = pk2(r[4], r[5]); o.w = pk2(r[6], r[7]);
                    *(u32x4*)(Gb + (size_t)(t0 + i) * 2816 + ca) = o;
                    a2 = a1; a1 = a0; b2 = b1; b1 = b0;
                }
            }
        }
#if !PER_PHASE_LAUNCH
        if (ph + 1 < ap->hi && p != 5) { if (ph == 0) grid.sync(); else xcd_barrier(xbar); }
#ifdef DBG_REPMASK
        if (((DBG_REPMASK >> pc) & 1) && (DBG_REP_LMASK >> l & 1) && !redo) { redo = 1; --ph; } else redo = 0;
#endif
#endif
    }
}

extern "C" void kernel_launch(void* const* d_in, const int* in_sizes, int n_in, void* d_out, int out_size, void* d_ws, size_t ws_size, hipStream_t stream) {
    static int grid = 0;
    if (grid == 0) {
        if (n_in != 29 || out_size != T_TOK * DM || ws_size < WS_END) { fprintf(stderr, "kernel_launch: unexpected problem (n_in %d, out %d, ws %zu < %zu)\n", n_in, out_size, ws_size, (size_t)WS_END); grid = -1; return; }
        int dev = 0, cus = 0, per_cu = 0;
        hipGetDevice(&dev); hipDeviceGetAttribute(&cus, hipDeviceAttributeMultiprocessorCount, dev);
        if (hipFuncSetAttribute((const void*)fwd_megakernel, hipFuncAttributeMaxDynamicSharedMemorySize, LDS_BYTES) != hipSuccess) fprintf(stderr, "kernel_launch: hipFuncSetAttribute failed\n");
        if (hipOccupancyMaxActiveBlocksPerMultiprocessor(&per_cu, (const void*)fwd_megakernel, 512, LDS_BYTES) != hipSuccess || per_cu < 1) { fprintf(stderr, "kernel_launch: occupancy query gave %d\n", per_cu); per_cu = 1; }
        (void)hipGetLastError();
        grid = cus * 1;
    }
    if (grid < 0) return;
    Args a{};
    for (int i = 0; i < 29; ++i) a.in[i] = (const float*)d_in[i];
    a.out = (float*)d_out; a.ws = (unsigned char*)d_ws;
#if PER_PHASE_LAUNCH
    for (int ph = 0; ph < NPHASES; ++ph) { a.lo = ph; a.hi = ph + 1; hipLaunchKernelGGL(fwd_megakernel, dim3(grid), dim3(512), LDS_BYTES, stream, a); }
#else
    a.lo = 0; a.hi = NPHASES;
    (void)hipMemsetAsync((unsigned char*)d_ws + OFF_BAR, 0, (OFF_XBUF - OFF_BAR), stream);
    void* kargs[] = {&a};
    hipError_t e = hipLaunchCooperativeKernel((const void*)fwd_megakernel, dim3(grid), dim3(512), kargs, LDS_BYTES, stream);
    if (e != hipSuccess) fprintf(stderr, "cooperative launch failed: %s (grid %d)\n", hipGetErrorString(e), grid);
#endif
}
```

```cpp
#include <hip/hip_runtime.h>
#include <hip/hip_cooperative_groups.h>
#include <cstdio>
namespace cg = cooperative_groups;

#ifndef PER_PHASE_LAUNCH
#define PER_PHASE_LAUNCH 0

#endif

namespace pg8 {
#define PG8_LAS __attribute__((address_space(3)))
typedef unsigned short bf16_t;
typedef short bf16x8 __attribute__((ext_vector_type(8)));
typedef float f32x4 __attribute__((ext_vector_type(4)));
typedef unsigned u32x4 __attribute__((ext_vector_type(4)));
constexpr int BM = 256, BK = 64, HALF = 128, HTB = HALF * BK * 2  , STAGE_BYTES = 8 * HTB, NXCD = 8, WGM = 8;

__host__ __device__ __forceinline__ int lds_byte(int r, int c) { const int st = (r >> 4) * 2 + (c >> 5), rr = r & 15, cc = c & 31, ob = rr * 64 + cc * 2; return st * 1024 + (ob ^ (((ob >> 9) & 1) << 5)); }
__host__ __device__ __forceinline__ void stage_rc(int b, int& R, int& C) { const int st = b / 1024, sb = b % 1024, swz = sb ^ (((sb >> 9) & 1) << 5); R = (st >> 1) * 16 + swz / 64; C = (st & 1) * 32 + (swz % 64) / 2; }
__host__ __device__ __forceinline__ int perm32(int rho) { const int n = rho >> 4, i = rho & 15; return 8 * (i >> 2) + 4 * n + (i & 3); }

struct Unit { int pm, pn; };
struct Gemm { const bf16_t* A; const bf16_t* Bt; int M, N, K; };

struct StaticOrder {
    int nM, nN, nwg, G, c;
    __host__ __device__ void init(int M, int N, int G_, int c_) { nM = M / BM; nN = N / BM; nwg = nM * nN; G = G_; c = c_; }
    int nextra = 0, xm = 1, pm0 = 0, pn0 = 0; const char* A2 = nullptr; const char* B2 = nullptr;
    __device__ __forceinline__ const char* abase(const Gemm& g, const Unit& u, size_t tstep) const { return u.pn >= pn0 && nextra ? A2 + (size_t)(u.pm - pm0) * tstep : (const char*)g.A + (size_t)u.pm * tstep; }
    __device__ __forceinline__ const char* bbase(const Gemm& g, const Unit& u, size_t tstep) const { return u.pn >= pn0 && nextra ? B2 + (size_t)(u.pn - pn0) * tstep : (const char*)g.Bt + (size_t)u.pn * tstep; }
    __host__ __device__ bool next(int i, Unit& u) const {
        const long L = (long)i * G + c; if (L >= nwg + nextra) return false;
        if (L >= nwg) { const int k = (int)(L - nwg); u.pm = pm0 + k % xm; u.pn = pn0 + k / xm; return true; }
        int wgid = (int)L; { const int q = nwg / NXCD, r = nwg % NXCD, xcd = wgid % NXCD, off = wgid / NXCD; wgid = (xcd < r ? xcd * (q + 1) : r * (q + 1) + (xcd - r) * q) + off; }
        const int nig = WGM * nN, gid = wgid / nig, fm = gid * WGM, gsz = (nM - fm) < WGM ? (nM - fm) : WGM;
        u.pm = fm + ((wgid % nig) % gsz); u.pn = (wgid % nig) / gsz; return true;
    }
    __device__ __forceinline__ void a_ready(const Unit&) const {}
    __device__ __forceinline__ void done(const Unit&) const {}
};
template <class Epi, class Sched>
__device__ __forceinline__ void gemm_phase(PG8_LAS unsigned char* lds, const Gemm g, const Sched& S, const Epi& E) {
    int tid = threadIdx.x; asm volatile("" : "+v"(tid)); const int wid = __builtin_amdgcn_readfirstlane(tid >> 6), lane = tid & 63, wr = wid >> 2, wc = wid & 3, fr = lane & 15, fq = lane >> 4;
    const int K = g.K, nt = K / BK;
    unsigned voffA[2], voffB[2];
#pragma unroll
    for (int i = 0; i < 2; ++i) { int R, C; stage_rc(tid * 16 + i * 8192, R, C); const int Rb = Epi::PERM ? ((R & ~31) + perm32(R & 31)) : R;
        voffA[i] = (unsigned)(R * K + C) * 2u; voffB[i] = (unsigned)(Rb * K + C) * 2u; }
    const size_t kstep = (size_t)(BK * 2);
    const size_t hstep = (size_t)HALF * K * 2;
    const size_t tstep = 2 * hstep;
    const unsigned ldsw = (unsigned)wid * 1024u;
    const int aoff = lds_byte(wr * 64 + fr, fq * 8), boff = lds_byte(wc * 32 + fr, fq * 8);
#define PG8_SA(b, h) (((b) * 2 + (h)) * HTB)
#define PG8_SB(b, h) ((4 + (b) * 2 + (h)) * HTB)
#define PG8_STAGE(bufoff, gbase, voff) do { _Pragma("unroll") for (int _i = 0; _i < 2; ++_i) \
        __builtin_amdgcn_global_load_lds((const unsigned*)((const char*)(gbase) + (voff)[_i]), (PG8_LAS unsigned*)(lds + (bufoff) + ldsw + _i * 8192), 16, 0, 0); } while (0)
#define PG8_LDA(dst, b, h) do { _Pragma("unroll") for (int m = 0; m < 4; ++m) _Pragma("unroll") for (int k = 0; k < 2; ++k) dst[m][k] = *(const PG8_LAS bf16x8*)(lds + PG8_SA(b, h) + aoff + m * 2048 + k * 1024); } while (0)
#define PG8_LDB(dst, b, h) do { _Pragma("unroll") for (int n = 0; n < 2; ++n) _Pragma("unroll") for (int k = 0; k < 2; ++k) dst[n][k] = *(const PG8_LAS bf16x8*)(lds + PG8_SB(b, h) + boff + n * 2048 + k * 1024); } while (0)
#define PG8_MMA(ai, bj, At, Bt) do { __builtin_amdgcn_s_setprio(1); _Pragma("unroll") for (int m = 0; m < 4; ++m) _Pragma("unroll") for (int n = 0; n < 2; ++n) _Pragma("unroll") for (int k = 0; k < 2; ++k) \
        acc[ai][bj][m][n] = __builtin_amdgcn_mfma_f32_16x16x32_bf16(Bt[n][k], At[m][k], acc[ai][bj][m][n], 0, 0, 0); __builtin_amdgcn_s_setprio(0); } while (0)
#define PG8_WAIT_V(n) asm volatile("s_waitcnt vmcnt(" #n ")" ::: "memory")
#define PG8_WAIT_L(n) asm volatile("s_waitcnt lgkmcnt(" #n ")" ::: "memory")
#define PG8_BAR __builtin_amdgcn_s_barrier()
#define PG8_SCHED __builtin_amdgcn_sched_barrier(0)
    Unit cur, nxt; int ui = 0;
    if (!S.next(0, cur)) return;
    f32x4 acc[2][2][4][2];
#pragma unroll
    for (int a = 0; a < 2; ++a)
#pragma unroll
        for (int b = 0; b < 2; ++b)
#pragma unroll
            for (int m = 0; m < 4; ++m)
#pragma unroll
                for (int n = 0; n < 2; ++n) acc[a][b][m][n] = (f32x4){0.f, 0.f, 0.f, 0.f};
    bf16x8 At[4][2], B0[2][2], B1[2][2];
    const char* cA = S.abase(g, cur, tstep); const char* cB = S.bbase(g, cur, tstep);
    S.a_ready(cur);
    PG8_STAGE(PG8_SB(0, 0), cB, voffB); PG8_STAGE(PG8_SA(0, 0), cA, voffA); PG8_STAGE(PG8_SB(0, 1), cB + hstep, voffB); PG8_STAGE(PG8_SA(0, 1), cA + hstep, voffA);
    if (wr == 1) PG8_BAR;
    PG8_WAIT_V(4); PG8_BAR;
    PG8_STAGE(PG8_SB(1, 0), cB + kstep, voffB); PG8_STAGE(PG8_SA(1, 0), cA + kstep, voffA); PG8_STAGE(PG8_SB(1, 1), cB + hstep + kstep, voffB);
    PG8_WAIT_V(6); PG8_BAR;
    for (;;) {
        const bool has_next = S.next(ui + 1, nxt);
        const char* nA = has_next ? S.abase(g, nxt, tstep) : cA; const char* nB = has_next ? S.bbase(g, nxt, tstep) : cB;
        for (int t = 0; t < nt; t += 2) {
            const bool last = (t == nt - 2);
            const char* a1 = cA + (size_t)(t + 1) * kstep;
            const char* a2 = last ? nA : cA + (size_t)(t + 2) * kstep; const char* b2 = last ? nB : cB + (size_t)(t + 2) * kstep;
            const char* a3 = a2 + kstep; const char* b3 = b2 + kstep;
            if (last && has_next) S.a_ready(nxt);
            PG8_LDB(B0, 0, 0); PG8_SCHED; PG8_LDA(At, 0, 0); PG8_STAGE(PG8_SA(1, 1), a1 + hstep, voffA);
            PG8_WAIT_L(8); PG8_BAR; PG8_WAIT_L(0); PG8_MMA(0, 0, At, B0); PG8_BAR; PG8_SCHED;
            PG8_LDB(B1, 0, 1); PG8_STAGE(PG8_SB(0, 0), b2, voffB);
            PG8_BAR; PG8_WAIT_L(0); PG8_MMA(0, 1, At, B1); PG8_BAR;
            PG8_LDA(At, 0, 1); PG8_STAGE(PG8_SA(0, 0), a2, voffA);
            PG8_BAR; PG8_WAIT_L(0); PG8_MMA(1, 0, At, B0); PG8_BAR; PG8_SCHED;
            PG8_STAGE(PG8_SB(0, 1), b2 + hstep, voffB);
            PG8_WAIT_V(6); PG8_BAR; PG8_MMA(1, 1, At, B1); PG8_BAR;
            PG8_LDB(B0, 1, 0); PG8_SCHED; PG8_LDA(At, 1, 0); PG8_STAGE(PG8_SA(0, 1), a2 + hstep, voffA);
            PG8_WAIT_L(8); PG8_BAR; PG8_WAIT_L(0); PG8_MMA(0, 0, At, B0); PG8_BAR; PG8_SCHED;
            PG8_LDB(B1, 1, 1); PG8_STAGE(PG8_SB(1, 0), b3, voffB);
            PG8_BAR; PG8_WAIT_L(0); PG8_MMA(0, 1, At, B1); PG8_BAR;
            PG8_LDA(At, 1, 1); PG8_STAGE(PG8_SA(1, 0), a3, voffA);
            PG8_BAR; PG8_WAIT_L(0); PG8_MMA(1, 0, At, B0); PG8_BAR; PG8_SCHED;
            PG8_STAGE(PG8_SB(1, 1), b3 + hstep, voffB);
            PG8_WAIT_V(6); PG8_BAR; PG8_MMA(1, 1, At, B1); PG8_BAR;
        }
        if constexpr (!Epi::AFTER_DRAIN) { E(acc, cur, wr, wc, fr, fq); S.done(cur); }
        if (!has_next) break;
#pragma unroll
        for (int a = 0; a < 2; ++a)
#pragma unroll
            for (int b = 0; b < 2; ++b)
#pragma unroll
                for (int m = 0; m < 4; ++m)
#pragma unroll
                    for (int n = 0; n < 2; ++n) acc[a][b][m][n] = (f32x4){0.f, 0.f, 0.f, 0.f};
        cur = nxt; cA = nA; cB = nB; ++ui;
    }
    PG8_WAIT_V(0);
    if (wr == 0) PG8_BAR;
    PG8_BAR;
    if constexpr (Epi::AFTER_DRAIN) { E.fused(acc, cur, wr, wc, fr, fq, lds, wid, lane); S.done(cur); }
#undef PG8_SA
#undef PG8_SB
#undef PG8_STAGE
#undef PG8_LDA
#undef PG8_LDB
#undef PG8_MMA
#undef PG8_WAIT_V
#undef PG8_WAIT_L
#undef PG8_BAR
#undef PG8_SCHED
}
}

#define LAS __attribute__((address_space(3)))
typedef unsigned short bf16_t;
typedef short bf16x8 __attribute__((ext_vector_type(8)));
typedef float f32x4 __attribute__((ext_vector_type(4)));
typedef unsigned u32x4 __attribute__((ext_vector_type(4)));
typedef unsigned u32x2 __attribute__((ext_vector_type(2)));

constexpr int T_TOK = 16384, DM = 1024;
constexpr size_t SL = 32ull << 20;
#define OFF_A(i) ((size_t)(i) * SL)
constexpr size_t OFF_W = 8 * SL, OFF_DT = OFF_W + (24ull << 20), OFF_VSQ = OFF_DT + (2ull << 20), OFF_CDEC = OFF_VSQ + (1ull << 20), OFF_BAR = OFF_CDEC + 65536, OFF_XCNT = OFF_BAR + 16384, OFF_XBUF = OFF_XCNT + 12 * 64 * 256, WS_END = OFF_XBUF + 12 * 64 * 256 * 4 * 4;
constexpr size_t MiB = 1ull << 20;
constexpr size_t OFF_KV = OFF_W + 18 * MiB, OFF_WKV = OFF_A(7), OFF_MEMN = OFF_A(7) + 4 * MiB;
constexpr int LDS_MISC = 149504, LDS_BYTES = LDS_MISC + 16;
constexpr float EPS = 1e-6f;

typedef float f32x2_t __attribute__((ext_vector_type(2)));
typedef __bf16 bf16x2_t __attribute__((ext_vector_type(2)));
__device__ __forceinline__ unsigned pk2(float lo, float hi) { const f32x2_t v = {lo, hi}; const bf16x2_t b = __builtin_convertvector(v, bf16x2_t); return __builtin_bit_cast(unsigned, b); }
__device__ __forceinline__ float bflo(unsigned w) { return __uint_as_float(w << 16); }
__device__ __forceinline__ float bfhi(unsigned w) { return __uint_as_float(w & 0xffff0000u); }
__device__ __forceinline__ float sigmoid_f(float x) { return __fdividef(1.f, 1.f + __expf(-x)); }
__device__ __forceinline__ float silu_f(float x) { return x * sigmoid_f(x); }
__device__ __forceinline__ float gelu_f(float x) { const float y = 1.5957691216f * (x + 0.044715f * x * x * x); return x * sigmoid_f(y); }
__device__ __forceinline__ float softplus_f(float x) { return fmaxf(x, 0.f) + log1pf(__expf(-fabsf(x))); }
__device__ __forceinline__ float wave_sum(float v) {
#pragma unroll
    for (int o = 1; o < 64; o <<= 1) v += __shfl_xor(v, o);
    return v;
}
__device__ __forceinline__ f32x4 mfma16(bf16x8 a, bf16x8 b, f32x4 c) { return __builtin_amdgcn_mfma_f32_16x16x32_bf16(a, b, c, 0, 0, 0); }
__device__ __forceinline__ bf16x8 frag_row(const LAS unsigned char* base, int strideB, int r0, int k0, int lane) {
    return *(const LAS bf16x8*)(base + (r0 + (lane & 15)) * strideB + (k0 + 8 * (lane >> 4)) * 2);
}
__device__ __forceinline__ bf16x8 frag_tr_gen(unsigned base_addr, int strideB, int k0, int c0, int lane, int grp_step, int second_off) {
    const int g = lane >> 4, q = (lane & 15) >> 2, p = lane & 3;
    const unsigned a0 = base_addr + (unsigned)((k0 + grp_step * g + q) * strideB + (c0 + 4 * p) * 2);
    const unsigned a1 = a0 + (unsigned)(second_off * strideB);
    u32x2 lo, hi;
    asm volatile("ds_read_b64_tr_b16 %0, %2\n\tds_read_b64_tr_b16 %1, %3\n\ts_waitcnt lgkmcnt(0)" : "=&v"(lo), "=&v"(hi) : "v"(a0), "v"(a1) : "memory");
    u32x4 r; r.x = lo.x; r.y = lo.y; r.z = hi.x; r.w = hi.y;
    return __builtin_bit_cast(bf16x8, r);
}
__device__ __forceinline__ bf16x8 frag_tr(unsigned base_addr, int strideB, int k0, int c0, int lane) { return frag_tr_gen(base_addr, strideB, k0, c0, lane, 8, 4); }
__device__ __forceinline__ unsigned lds_addr(const LAS unsigned char* p) { return (unsigned)(unsigned long long)(const LAS void*)p; }


#define PPERM(i) (32 * ((i) >> 1) + 4 * ((i) & 1))
template <bool PERM = false>
__device__ __forceinline__ void frag_tr_x4(unsigned base_addr, int strideB, int k0, int c0, int cstep, int lane, int grp_step, int second_off, bf16x8 (&out)[4]) {
    const int g = lane >> 4, q = (lane & 15) >> 2, p = lane & 3;
    const unsigned a0 = base_addr + (unsigned)((k0 + grp_step * g + q) * strideB + (c0 + (PERM ? 8 : 4) * p) * 2), b0 = a0 + (unsigned)(second_off * strideB), cs = (unsigned)(cstep * 2);
    if (PERM) {
        u32x2 l0, h0, l1, h1, l2, h2, l3, h3;
        asm volatile("ds_read_b64_tr_b16 %0, %8\n\tds_read_b64_tr_b16 %1, %9\n\tds_read_b64_tr_b16 %2, %10\n\tds_read_b64_tr_b16 %3, %11\n\t"
                     "ds_read_b64_tr_b16 %4, %12\n\tds_read_b64_tr_b16 %5, %13\n\tds_read_b64_tr_b16 %6, %14\n\tds_read_b64_tr_b16 %7, %15\n\ts_waitcnt lgkmcnt(0)"
                     : "=&v"(l0), "=&v"(h0), "=&v"(l1), "=&v"(h1), "=&v"(l2), "=&v"(h2), "=&v"(l3), "=&v"(h3)
                     : "v"(a0), "v"(b0), "v"(a0 + 8u), "v"(b0 + 8u), "v"(a0 + 64u), "v"(b0 + 64u), "v"(a0 + 72u), "v"(b0 + 72u) : "memory");
        u32x4 r;
        r.x = l0.x; r.y = l0.y; r.z = h0.x; r.w = h0.y; out[0] = __builtin_bit_cast(bf16x8, r);
        r.x = l1.x; r.y = l1.y; r.z = h1.x; r.w = h1.y; out[1] = __builtin_bit_cast(bf16x8, r);
        r.x = l2.x; r.y = l2.y; r.z = h2.x; r.w = h2.y; out[2] = __builtin_bit_cast(bf16x8, r);
        r.x = l3.x; r.y = l3.y; r.z = h3.x; r.w = h3.y; out[3] = __builtin_bit_cast(bf16x8, r);
        return;
    }
    u32x2 l0, h0, l1, h1, l2, h2, l3, h3;
    asm volatile("ds_read_b64_tr_b16 %0, %8\n\tds_read_b64_tr_b16 %1, %9\n\tds_read_b64_tr_b16 %2, %10\n\tds_read_b64_tr_b16 %3, %11\n\t"
                 "ds_read_b64_tr_b16 %4, %12\n\tds_read_b64_tr_b16 %5, %13\n\tds_read_b64_tr_b16 %6, %14\n\tds_read_b64_tr_b16 %7, %15\n\ts_waitcnt lgkmcnt(0)"
                 : "=&v"(l0), "=&v"(h0), "=&v"(l1), "=&v"(h1), "=&v"(l2), "=&v"(h2), "=&v"(l3), "=&v"(h3)
                 : "v"(a0), "v"(b0), "v"(a0 + cs), "v"(b0 + cs), "v"(a0 + 2 * cs), "v"(b0 + 2 * cs), "v"(a0 + 3 * cs), "v"(b0 + 3 * cs) : "memory");
    u32x4 r;
    r.x = l0.x; r.y = l0.y; r.z = h0.x; r.w = h0.y; out[0] = __builtin_bit_cast(bf16x8, r);
    r.x = l1.x; r.y = l1.y; r.z = h1.x; r.w = h1.y; out[1] = __builtin_bit_cast(bf16x8, r);
    r.x = l2.x; r.y = l2.y; r.z = h2.x; r.w = h2.y; out[2] = __builtin_bit_cast(bf16x8, r);
    r.x = l3.x; r.y = l3.y; r.z = h3.x; r.w = h3.y; out[3] = __builtin_bit_cast(bf16x8, r);
}


#define XB_TMO      128
#define XB_XCNT(j)  (256  + 64 * (j))
#define XB_XSUB(j)  (1280 + 64 * (j))
#define XB_XGEN(j)  (2304 + 64 * (j))
#define XB_TOP      3328
#define XB_TOPGEN   3392
#define XCD_BAR_WORDS 3456
#define XB_SPIN_CAP (1u << 18)

__device__ __forceinline__ unsigned xb_ld(unsigned* p)              { return __hip_atomic_load(p, __ATOMIC_RELAXED, __HIP_MEMORY_SCOPE_AGENT); }
__device__ __forceinline__ unsigned xb_add(unsigned* p, unsigned v) { return __hip_atomic_fetch_add(p, v, __ATOMIC_RELAXED, __HIP_MEMORY_SCOPE_AGENT); }
__device__ __forceinline__ unsigned xb_xcc_id() { return (unsigned)__builtin_amdgcn_s_getreg((3 << 11) | 20) & 0xFu; }
#define XB_SPIN(cond, bar) do { unsigned _sp = 0; while (cond) { __builtin_amdgcn_s_sleep(1); \
    if ((++_sp & 255u) == 0u) { if (xb_ld(&(bar)[XB_TMO])) break; if (_sp > XB_SPIN_CAP) { atomicAdd(&(bar)[XB_TMO], 1u); break; } } } } while (0)

struct XcdBarrier {
    unsigned* bar; unsigned x;
    volatile LAS unsigned* st;
};

__device__ __forceinline__ XcdBarrier xcd_barrier_post(unsigned* bar, volatile LAS unsigned* st) {
    XcdBarrier b; b.bar = bar; b.x = xb_xcc_id(); b.st = st;
    if (threadIdx.x == 0) (void)xb_add(&bar[XB_XCNT(b.x)], 1u);
    return b;
}
__device__ __forceinline__ void xcd_barrier_complete(unsigned* bar, unsigned x, unsigned& nloc, unsigned& nx) {
    const unsigned G = gridDim.x * gridDim.y * gridDim.z;
    unsigned sum, cnt, mine, sp = 0u;
    for (;;) {
        sum = 0u; cnt = 0u; mine = 0u;
#pragma unroll
        for (unsigned j = 0; j < 16; ++j) { const unsigned c = xb_ld(&bar[XB_XCNT(j)]); sum += c; cnt += (c > 0u) ? 1u : 0u; mine = (j == x) ? c : mine; }
        if (sum == G) break;
        __builtin_amdgcn_s_sleep(1);
        if ((++sp & 255u) == 0u) { if (xb_ld(&bar[XB_TMO])) break; if (sp > XB_SPIN_CAP) { atomicAdd(&bar[XB_TMO], 1u); break; } }
    }
    nloc = mine > 0u ? mine : 1u; nx = cnt > 0u ? cnt : 1u;
}

__device__ __forceinline__ void xcd_barrier(const XcdBarrier& b) {
    asm volatile("s_waitcnt vmcnt(0)" ::: "memory");
    __syncthreads();
    if (threadIdx.x == 0) {
        unsigned* bar = b.bar;
        __builtin_amdgcn_s_waitcnt(0);
        unsigned nloc = b.st[0], nx = b.st[1];
        if (nloc == 0u) { xcd_barrier_complete(bar, b.x, nloc, nx); b.st[0] = nloc; b.st[1] = nx; }
        const unsigned old = xb_add(&bar[XB_XSUB(b.x)], 1u);
        const unsigned gen = old / nloc;
        if (old + 1u == (gen + 1u) * nloc) {
            __builtin_amdgcn_fence(__ATOMIC_RELEASE, "agent");
            asm volatile("s_waitcnt vmcnt(0)" ::: "memory");
            const unsigned og = xb_add(&bar[XB_TOP], 1u);
            const unsigned tg = og / nx;
            if (og + 1u == (tg + 1u) * nx) xb_add(&bar[XB_TOPGEN], 1u);
            else XB_SPIN(xb_ld(&bar[XB_TOPGEN]) == tg, bar);
            __builtin_amdgcn_fence(__ATOMIC_ACQUIRE, "agent");
            xb_add(&bar[XB_XGEN(b.x)], 1u);
            asm volatile("s_waitcnt vmcnt(0)" ::: "memory");
        } else {
            XB_SPIN(xb_ld(&bar[XB_XGEN(b.x)]) == gen, bar);
            __builtin_amdgcn_fence(__ATOMIC_ACQUIRE, "agent");
            asm volatile("s_waitcnt vmcnt(0)" ::: "memory");
        }
    }
    __syncthreads();
}

struct Args { const float* in[29]; float* out; unsigned char* ws; int lo, hi; };

enum { M_NONE = 0, M_GELU, M_GELUSQ, M_SIGMOID, M_SILU, M_DT, M_MULG, M_ADDMULG };
struct GD { unsigned long long a, b, aux; unsigned long long o[4]; int pb[4], m[4], ld[4]; int M, N, K, isgemm; };
struct EpiGen {
    static constexpr bool PERM = true, AFTER_DRAIN = false;
    const GD* d; unsigned char* ws;
    float* f32o; const float* bias; float* sq;
    template <int MODE> __device__ __forceinline__ void run(const f32x4 (&acc)[2][2][4][2], bf16_t* base, const bf16_t* aux, int ld, int row0, int col0, int pnl, int wc, int fq) const {
#pragma unroll
        for (int ai = 0; ai < 2; ++ai) {
            u32x4 gall[4][2], aall[4][2];
#pragma unroll
            for (int m = 0; m < 4; ++m) {
                if ((m & 1) == 0) {
                    if (MODE == M_MULG || MODE == M_ADDMULG) {
#pragma unroll
                        for (int mm = m; mm < m + 2; ++mm) { const bf16_t* rp = base + (size_t)(row0 + ai * 128 + mm * 16) * ld + col0; gall[mm][0] = *(const u32x4*)(rp); gall[mm][1] = *(const u32x4*)(rp + 128); }
                    }
                    if (MODE == M_ADDMULG) {
#pragma unroll
                        for (int mm = m; mm < m + 2; ++mm) { const bf16_t* rp = aux + (size_t)(row0 + ai * 128 + mm * 16) * ld + col0; aall[mm][0] = *(const u32x4*)(rp); aall[mm][1] = *(const u32x4*)(rp + 128); }
                    }
                }
                const size_t row = (size_t)(row0 + ai * 128 + m * 16);
                bf16_t* rowp = base + row * ld + col0;
                float sqs = 0.f;
                u32x4 gld[2], ald[2];
                if (MODE == M_MULG || MODE == M_ADDMULG) { gld[0] = gall[m][0]; gld[1] = gall[m][1]; }
                if (MODE == M_ADDMULG) { ald[0] = aall[m][0]; ald[1] = aall[m][1]; }
#pragma unroll
                for (int bj = 0; bj < 2; ++bj) {
                    f32x4 v0 = acc[ai][bj][m][0], v1 = acc[ai][bj][m][1];
                    if (MODE == M_DT) {
                        if (bj == 0 && wc == 0) {
                            const f32x4 b0 = *(const f32x4*)(bias + 8 * fq), b1 = *(const f32x4*)(bias + 8 * fq + 4);
                            f32x4 r0, r1;
#pragma unroll
                            for (int e = 0; e < 4; ++e) { r0[e] = softplus_f(v0[e] + b0[e]); r1[e] = softplus_f(v1[e] + b1[e]); }
                            *(f32x4*)(f32o + row * 32 + 8 * fq) = r0; *(f32x4*)(f32o + row * 32 + 8 * fq + 4) = r1;
                        }
                        continue;
                    }
#pragma unroll
                    for (int e = 0; e < 4; ++e) {
                        if (MODE == M_GELU || MODE == M_GELUSQ) { v0[e] = gelu_f(v0[e]); v1[e] = gelu_f(v1[e]); }
                        if (MODE == M_SIGMOID) { v0[e] = sigmoid_f(v0[e]); v1[e] = sigmoid_f(v1[e]); }
                        if (MODE == M_SILU) { v0[e] = silu_f(v0[e]); v1[e] = silu_f(v1[e]); }
                        if (MODE == M_GELUSQ) sqs += v0[e] * v0[e] + v1[e] * v1[e];
                    }
                    if (MODE == M_MULG || MODE == M_ADDMULG) {
                        const u32x4 g = gld[bj];
                        v0[0] *= bflo(g.x); v0[1] *= bfhi(g.x); v0[2] *= bflo(g.y); v0[3] *= bfhi(g.y);
                        v1[0] *= bflo(g.z); v1[1] *= bfhi(g.z); v1[2] *= bflo(g.w); v1[3] *= bfhi(g.w);
                    }
                    if (MODE == M_ADDMULG) {
                        const u32x4 g = ald[bj];
                        v0[0] += bflo(g.x); v0[1] += bfhi(g.x); v0[2] += bflo(g.y); v0[3] += bfhi(g.y);
                        v1[0] += bflo(g.z); v1[1] += bfhi(g.z); v1[2] += bflo(g.w); v1[3] += bfhi(g.w);
                    }
                    u32x4 w; w.x = pk2(v0[0], v0[1]); w.y = pk2(v0[2], v0[3]); w.z = pk2(v1[0], v1[1]); w.w = pk2(v1[2], v1[3]);
                    *(u32x4*)(rowp + bj * 128) = w;
                }
                if (MODE == M_GELUSQ) {
                    sqs += __shfl_xor(sqs, 16); sqs += __shfl_xor(sqs, 32);
                    if (fq == 0) sq[row * 16 + pnl * 4 + wc] = sqs;
                }
            }
        }
    }
    __device__ __forceinline__ void operator()(const f32x4 (&acc)[2][2][4][2], const pg8::Unit& u, int wr, int wc, int fr, int fq) const {
        const int pn = u.pn, s = (pn >= d->pb[1]) + (pn >= d->pb[2]) + (pn >= d->pb[3]);
        const int mode = d->m[s], ld = d->ld[s], pnl = pn - d->pb[s];
        bf16_t* base = (bf16_t*)(ws + d->o[s]);
        const bf16_t* aux = (const bf16_t*)(ws + d->aux);
        const int row0 = u.pm * 256 + wr * 64 + fr, col0 = pnl * 256 + wc * 32 + 8 * fq;
        switch (mode) {
            case M_NONE: run<M_NONE>(acc, base, aux, ld, row0, col0, pnl, wc, fq); break;
            case M_GELU: run<M_GELU>(acc, base, aux, ld, row0, col0, pnl, wc, fq); break;
            case M_GELUSQ: run<M_GELUSQ>(acc, base, aux, ld, row0, col0, pnl, wc, fq); break;
            case M_SIGMOID: run<M_SIGMOID>(acc, base, aux, ld, row0, col0, pnl, wc, fq); break;
            case M_SILU: run<M_SILU>(acc, base, aux, ld, row0, col0, pnl, wc, fq); break;
            case M_DT: run<M_DT>(acc, base, aux, ld, row0, col0, pnl, wc, fq); break;
            case M_MULG: run<M_MULG>(acc, base, aux, ld, row0, col0, pnl, wc, fq); break;
            default: run<M_ADDMULG>(acc, base, aux, ld, row0, col0, pnl, wc, fq); break;
        }
    }
};

__device__ __forceinline__ void cv_item(const float* W, int K, int N, int k0, int n0, bf16_t* WT, int dst_row0, LAS float* scr, int lane) {
    float wv[32];
#pragma unroll
    for (int i = 0; i < 32; ++i) wv[i] = W[(size_t)(k0 + 2 * i + (lane >> 5)) * N + n0 + (lane & 31)];
#pragma unroll
    for (int i = 0; i < 32; ++i) scr[(2 * i + (lane >> 5)) * 33 + (lane & 31)] = wv[i];
    asm volatile("s_waitcnt lgkmcnt(0)" ::: "memory");
    const int c = lane & 7;
#pragma unroll
    for (int j = 0; j < 4; ++j) { const int n = (lane >> 3) + 8 * j; const LAS float* s = scr + (8 * c) * 33 + n;
        u32x4 o; o.x = pk2(s[0 * 33], s[1 * 33]); o.y = pk2(s[2 * 33], s[3 * 33]); o.z = pk2(s[4 * 33], s[5 * 33]); o.w = pk2(s[6 * 33], s[7 * 33]);
        *(u32x4*)(WT + (size_t)(dst_row0 + n) * K + k0 + 8 * c) = o; }
    asm volatile("s_waitcnt lgkmcnt(0)" ::: "memory");
}
__device__ __forceinline__ void cv_job(const float* W, int K, int N, int c0, int ncols, bf16_t* WT, int r0, bool ileave, LAS float* scr, int& gw0, int NGW, int lane) {
    const int nnb = ncols / 32, nitems = (K / 64) * nnb;
    const int first = gw0; gw0 = (gw0 + NGW - nitems % NGW) % NGW;
    for (int it = first; it < nitems; it += NGW) {
        const int kb = it / nnb, nb = it - kb * nnb, c = 32 * nb;
        int dst = r0 + c;
        if (ileave) { dst = c < 2816 ? (256 * (c >> 7) + (c & 127)) : (256 * ((c - 2816) >> 7) + 128 + ((c - 2816) & 127)); }
        cv_item(W, K, N, 64 * kb, c0 + c, WT, dst, scr, lane);
    }
}

template <bool POST, bool PRE>
__device__ __forceinline__ void norm_rows(const float* xsrc, float* xdst, const bf16_t* O, const float* gpost, const float* gpre, bf16_t* H, int M, int gw, int NGW, int lane) {
#ifndef DBG_REPMASK
#pragma unroll 4
#endif
    for (int m = gw; m < M; m += NGW) {
        f32x4 v[4];
#pragma unroll
        for (int j = 0; j < 4; ++j) v[j] = ((const f32x4*)(xsrc + (size_t)m * DM))[lane + 64 * j];
        if (POST) {
            f32x4 y[4]; float ss = 0.f;
#pragma unroll
            for (int j = 0; j < 4; ++j) { const u32x2 o = ((const u32x2*)(O + (size_t)m * DM))[lane + 64 * j]; y[j][0] = bflo(o.x); y[j][1] = bfhi(o.x); y[j][2] = bflo(o.y); y[j][3] = bfhi(o.y);
                ss += (y[j][0] * y[j][0] + y[j][1] * y[j][1]) + (y[j][2] * y[j][2] + y[j][3] * y[j][3]); }
            const float r = rsqrtf(wave_sum(ss) * (1.f / DM) + EPS);
#pragma unroll
            for (int j = 0; j < 4; ++j) { const f32x4 g = ((const f32x4*)gpost)[lane + 64 * j]; v[j] += y[j] * r * g; ((f32x4*)(xdst + (size_t)m * DM))[lane + 64 * j] = v[j]; }
        }
        if (PRE) {
            float ss = 0.f;
#pragma unroll
            for (int j = 0; j < 4; ++j) ss += (v[j][0] * v[j][0] + v[j][1] * v[j][1]) + (v[j][2] * v[j][2] + v[j][3] * v[j][3]);
            const float r = rsqrtf(wave_sum(ss) * (1.f / DM) + EPS);
#pragma unroll
            for (int j = 0; j < 4; ++j) { const f32x4 g = ((const f32x4*)gpre)[lane + 64 * j]; const f32x4 o = v[j] * r * g; u32x2 w; w.x = pk2(o[0], o[1]); w.y = pk2(o[2], o[3]);
                ((u32x2*)(H + (size_t)m * DM))[lane + 64 * j] = w; }
        }
    }
}

template <int NCOL, bool SCALE>
__device__ __forceinline__ void load_conv_tile(LAS unsigned char* dst, int strideB, const bf16_t* raw, int ch0, bool first, const float* cw, const float* cb, const LAS float* wsc, int tid) {
    constexpr int CG = NCOL / 8, TR = 512 / CG, RUN = 128 / TR;
    const int cgi = tid % CG, tr = tid / CG, ch = ch0 + cgi * 8, s0 = tr * RUN;
    float w[4][8], bias[8];
#pragma unroll
    for (int k = 0; k < 4; ++k) { const f32x4 a = *(const f32x4*)(cw + k * 3072 + ch), b = *(const f32x4*)(cw + k * 3072 + ch + 4);
#pragma unroll
        for (int e = 0; e < 4; ++e) { w[k][e] = a[e]; w[k][4 + e] = b[e]; } }
    { const f32x4 a = *(const f32x4*)(cb + ch), b = *(const f32x4*)(cb + ch + 4);
#pragma unroll
        for (int e = 0; e < 4; ++e) { bias[e] = a[e]; bias[4 + e] = b[e]; } }
    u32x4 rows[RUN + 3];
#pragma unroll
    for (int r = 0; r < RUN + 3; ++r) { const int sr = s0 - 3 + r;
        rows[r] = (sr >= 0 || !first) ? *(const u32x4*)(raw + (long)sr * 3072 + ch) : (u32x4){0u, 0u, 0u, 0u}; }
#pragma unroll
    for (int i = 0; i < RUN; ++i) {
        float acc[8];
#pragma unroll
        for (int e = 0; e < 8; ++e) acc[e] = bias[e];
#pragma unroll
        for (int k = 0; k < 4; ++k) { const u32x4 v = rows[i + k];
            acc[0] += w[k][0] * bflo(v.x); acc[1] += w[k][1] * bfhi(v.x); acc[2] += w[k][2] * bflo(v.y); acc[3] += w[k][3] * bfhi(v.y);
            acc[4] += w[k][4] * bflo(v.z); acc[5] += w[k][5] * bfhi(v.z); acc[6] += w[k][6] * bflo(v.w); acc[7] += w[k][7] * bfhi(v.w); }
        float sc = 1.f;
        if (SCALE) sc = wsc[(cgi >> 3) * 128 + s0 + i];
#pragma unroll
        for (int e = 0; e < 8; ++e) acc[e] = silu_f(acc[e]) * sc;
        u32x4 o; o.x = pk2(acc[0], acc[1]); o.y = pk2(acc[2], acc[3]); o.z = pk2(acc[4], acc[5]); o.w = pk2(acc[6], acc[7]);
        *(LAS u32x4*)(dst + (s0 + i) * strideB + cgi * 16) = o;
    }
}
__device__ __forceinline__ void ssd_dt_scan(const float* dtbuf, int rowbase, int h, float a, int lane, float& d0, float& d1, float& c0, float& c1, float& total) {
    d0 = dtbuf[(size_t)(rowbase + 2 * lane) * 32 + h]; d1 = dtbuf[(size_t)(rowbase + 2 * lane + 1) * 32 + h];
    const float v0 = d0 * a, v1 = d1 * a; float x = v0 + v1;
#pragma unroll
    for (int o = 1; o < 64; o <<= 1) { const float y = __shfl_up(x, o); if (lane >= o) x += y; }
    c1 = x; c0 = x - v1; total = __shfl(x, 63);
}

constexpr int NPH_LAYER = 21, NPHASES = 1 + 2 * NPH_LAYER;


struct RmsXchg { unsigned* xbuf; unsigned* cnt; };
__device__ __forceinline__ void rms_exchange(const f32x4 (&v)[2][2][4][2], const pg8::Unit& u, int wr, int wc, int fr, int fq, LAS unsigned char* lds, int wid, int lane, const RmsXchg X) {
    LAS float* P = (LAS float*)lds;
    LAS float* S = (LAS float*)(lds + 4096);
#pragma unroll
    for (int ai = 0; ai < 2; ++ai)
#pragma unroll
        for (int m = 0; m < 4; ++m) {
            float s = 0.f;
#pragma unroll
            for (int bj = 0; bj < 2; ++bj)
#pragma unroll
                for (int n = 0; n < 2; ++n) { const f32x4 x = v[ai][bj][m][n]; s += (x[0] * x[0] + x[1] * x[1]) + (x[2] * x[2] + x[3] * x[3]); }
            s += __shfl_xor(s, 16); s += __shfl_xor(s, 32);
            if (fq == 0) P[(ai * 128 + wr * 64 + m * 16 + fr) * 4 + wc] = s;
        }
    asm volatile("s_waitcnt lgkmcnt(0)" ::: "memory"); __builtin_amdgcn_s_barrier(); asm volatile("" ::: "memory");
    const int row = wid * 32 + (lane & 31);
    if (lane < 32) {
        const float t = (P[row * 4 + 0] + P[row * 4 + 1]) + (P[row * 4 + 2] + P[row * 4 + 3]);
        __hip_atomic_store(X.xbuf + ((size_t)(u.pm * 256 + row)) * 4 + u.pn, __float_as_uint(t), __ATOMIC_RELAXED, __HIP_MEMORY_SCOPE_AGENT);
    }
    asm volatile("s_waitcnt vmcnt(0)" ::: "memory");
    if (lane == 0) __hip_atomic_fetch_add(X.cnt + 64 * u.pm, 1u, __ATOMIC_RELAXED, __HIP_MEMORY_SCOPE_AGENT);
    if (wid == 0) {
        unsigned spins = 0;
        while ((unsigned)__builtin_amdgcn_readfirstlane(__hip_atomic_load(X.cnt + 64 * u.pm, __ATOMIC_RELAXED, __HIP_MEMORY_SCOPE_AGENT)) < 32u && ++spins < (1u << 20)) __builtin_amdgcn_s_sleep(2);
        __builtin_amdgcn_fence(__ATOMIC_ACQUIRE, "agent");
    }
    asm volatile("s_waitcnt vmcnt(0) lgkmcnt(0)" ::: "memory"); __builtin_amdgcn_s_barrier(); asm volatile("" ::: "memory");
    if (lane < 32) {
        const unsigned* slot = X.xbuf + ((size_t)(u.pm * 256 + row)) * 4;
        float t = 0.f;
#pragma unroll
        for (int k = 0; k < 4; ++k) t += __uint_as_float(__hip_atomic_load(slot + k, __ATOMIC_RELAXED, __HIP_MEMORY_SCOPE_AGENT));
        S[row] = rsqrtf(t * (1.f / 1024.f) + EPS);
    }
    asm volatile("s_waitcnt lgkmcnt(0)" ::: "memory"); __builtin_amdgcn_s_barrier(); asm volatile("" ::: "memory");
}
struct EpiNorm {
    static constexpr bool PERM = false, AFTER_DRAIN = true;
    const float* xsrc; float* xdst; bf16_t* H; const float* gpost; const float* gpre; RmsXchg x1, x2; int pre;
    __device__ __forceinline__ void fused(f32x4 (&acc)[2][2][4][2], const pg8::Unit& u, int wr, int wc, int fr, int fq, LAS unsigned char* lds, int wid, int lane) const {
        const LAS float* S = (const LAS float*)(lds + 4096);
        LAS unsigned char* T = lds + 8192;
        const int tid = wid * 64 + lane;
        const int col0 = wc * 32 + 4 * fq;
        rms_exchange(acc, u, wr, wc, fr, fq, lds, wid, lane, x1);
        f32x4 gp[2][2];
#pragma unroll
        for (int bj = 0; bj < 2; ++bj)
#pragma unroll
            for (int n = 0; n < 2; ++n) gp[bj][n] = *(const f32x4*)(gpost + u.pn * 256 + col0 + bj * 128 + n * 16);
#pragma unroll
        for (int ai = 0; ai < 2; ++ai) {
            const size_t g0 = (size_t)(u.pm * 256 + ai * 128) * 1024 + u.pn * 256;
#pragma unroll
            for (int hb = 0; hb < 2; ++hb) {
                f32x4 t[8];
#pragma unroll
                for (int i = 0; i < 8; ++i) t[i] = *(const f32x4*)(xsrc + g0 + (size_t)((tid >> 6) + 8 * (8 * hb + i)) * 1024 + (tid & 63) * 4);
#pragma unroll
                for (int i = 0; i < 8; ++i) *(LAS f32x4*)(T + ((tid >> 6) + 8 * (8 * hb + i)) * 1040 + (tid & 63) * 16) = t[i];
            }
            asm volatile("s_waitcnt lgkmcnt(0)" ::: "memory"); __builtin_amdgcn_s_barrier(); asm volatile("" ::: "memory");
#pragma unroll
            for (int m = 0; m < 4; ++m) {
                const int r = wr * 64 + m * 16 + fr; const float sr = S[ai * 128 + r];
#pragma unroll
                for (int bj = 0; bj < 2; ++bj)
#pragma unroll
                    for (int n = 0; n < 2; ++n) { LAS f32x4* p = (LAS f32x4*)(T + r * 1040 + (col0 + bj * 128 + n * 16) * 4);
                        const f32x4 v = acc[ai][bj][m][n] * sr * gp[bj][n] + *p;
                        acc[ai][bj][m][n] = v; *p = v; }
            }
            asm volatile("s_waitcnt lgkmcnt(0)" ::: "memory"); __builtin_amdgcn_s_barrier(); asm volatile("" ::: "memory");
#pragma unroll
            for (int i = 0; i < 16; ++i) { const int row = (tid >> 6) + 8 * i;
                *(f32x4*)(xdst + g0 + (size_t)row * 1024 + (tid & 63) * 4) = *(const LAS f32x4*)(T + row * 1040 + (tid & 63) * 16); }
            asm volatile("s_waitcnt lgkmcnt(0)" ::: "memory"); __builtin_amdgcn_s_barrier(); asm volatile("" ::: "memory");
        }
        if (pre) {
            rms_exchange(acc, u, wr, wc, fr, fq, lds, wid, lane, x2);
#pragma unroll
            for (int bj = 0; bj < 2; ++bj)
#pragma unroll
                for (int n = 0; n < 2; ++n) gp[bj][n] = *(const f32x4*)(gpre + u.pn * 256 + col0 + bj * 128 + n * 16);
#pragma unroll
            for (int ai = 0; ai < 2; ++ai) {
                const size_t g0 = (size_t)(u.pm * 256 + ai * 128) * 1024 + u.pn * 256;
#pragma unroll
                for (int m = 0; m < 4; ++m) {
                    const int r = wr * 64 + m * 16 + fr; const float sr = S[ai * 128 + r];
#pragma unroll
                    for (int bj = 0; bj < 2; ++bj)
#pragma unroll
                        for (int n = 0; n < 2; ++n) { const f32x4 o = acc[ai][bj][m][n] * sr * gp[bj][n];
                            u32x2 w; w.x = pk2(o[0], o[1]); w.y = pk2(o[2], o[3]); *(LAS u32x2*)(T + r * 528 + (col0 + bj * 128 + n * 16) * 2) = w; }
                }
                asm volatile("s_waitcnt lgkmcnt(0)" ::: "memory"); __builtin_amdgcn_s_barrier(); asm volatile("" ::: "memory");
#pragma unroll
                for (int i = 0; i < 8; ++i) { const int row = (tid >> 5) + 16 * i;
                    *(u32x4*)(H + g0 + (size_t)row * 1024 + (tid & 31) * 8) = *(const LAS u32x4*)(T + row * 528 + (tid & 31) * 16); }
                asm volatile("s_waitcnt lgkmcnt(0)" ::: "memory"); __builtin_amdgcn_s_barrier(); asm volatile("" ::: "memory");
            }
        }
    }
};

#define BIGP (1 << 20)
#define GD_NONE {0, 0, 0, {0, 0, 0, 0}, {0, BIGP, BIGP, BIGP}, {0, 0, 0, 0}, {0, 0, 0, 0}, 0, 0, 0, 0}
#define GD_SIMPLE(A_, B_, O_, M_, N_, K_, MODE_, LD_, AUX_) {A_, B_, AUX_, {O_, O_, O_, O_}, {0, BIGP, BIGP, BIGP}, {MODE_, MODE_, MODE_, MODE_}, {LD_, LD_, LD_, LD_}, M_, N_, K_, 1}
__device__ const GD GDT[NPH_LAYER] = {
      {OFF_A(0), OFF_W, 0, {OFF_A(1), OFF_A(3), OFF_A(3), OFF_KV - (unsigned long long)T_TOK * 2048 * 2}, {0, 8, 20, 21}, {M_SILU, M_NONE, M_DT, M_NONE}, {2048, 3072, 3072, 2048}, T_TOK, 5376, 1024, 1},
      GD_NONE,   GD_NONE,   GD_NONE,
      {OFF_A(0), OFF_W, 0, {OFF_A(3), OFF_A(4), OFF_A(5), OFF_A(6)}, {0, 4, 8, 12}, {M_GELU, M_GELUSQ, M_SIGMOID, M_SIGMOID}, {1024, 1024, 1024, 1024}, T_TOK, 4096, 1024, 1},
      GD_NONE,
      GD_SIMPLE(OFF_A(1), OFF_W + 10 * MiB, OFF_A(6), T_TOK, 1024, 2048, M_MULG, 1024, 0),
      GD_SIMPLE(OFF_A(3), OFF_W + 8 * MiB, OFF_A(5), T_TOK, 1024, 1024, M_ADDMULG, 1024, OFF_A(6)),
      GD_SIMPLE(OFF_A(5), OFF_W + 14 * MiB, OFF_A(1), T_TOK, 1024, 1024, M_NONE, 1024, 0),
      GD_NONE,
      GD_SIMPLE(OFF_A(0), OFF_W, OFF_A(1), T_TOK, 1024, 1024, M_NONE, 1024, 0),
      GD_SIMPLE(OFF_A(2), OFF_W + 2 * MiB, OFF_A(3), 1024, 2048, 1024, M_NONE, 2048, 0),
      GD_NONE,
      GD_SIMPLE(OFF_A(4), OFF_W + 22 * MiB, OFF_A(1), T_TOK, 1024, 1024, M_NONE, 1024, 0),
      GD_NONE,
      GD_SIMPLE(OFF_A(0), OFF_W, OFF_A(1), T_TOK, 2816, 1024, M_NONE, 2816, 0),
      GD_NONE,
      GD_SIMPLE(OFF_A(0), OFF_W + 2816ull * 1024 * 2, OFF_A(1), T_TOK, 2816, 1024, M_NONE, 2816, 0),
      GD_NONE,
      GD_SIMPLE(OFF_A(4), OFF_W + 12 * MiB, OFF_A(1), T_TOK, 1024, 2816, M_NONE, 1024, 0),
      GD_NONE,
};

__global__ void __launch_bounds__(512, 2) fwd_megakernel(Args args) {
    extern __shared__ __attribute__((aligned(16))) unsigned char lds_raw[];
    LAS unsigned char* lds = (LAS unsigned char*)lds_raw;
    cg::grid_group grid = cg::this_grid();
    const int G = gridDim.x, NGW = G * 8;
    volatile LAS unsigned* xst = (volatile LAS unsigned*)(lds + LDS_MISC);
    if (threadIdx.x < 4) xst[threadIdx.x] = 0u;
    __syncthreads();
    XcdBarrier xbar = xcd_barrier_post((unsigned*)(args.ws + OFF_BAR), xst);

#ifdef DBG_REPMASK
    int redo = 0;
#endif
#pragma unroll 1
    for (int ph = args.lo; ph < args.hi; ++ph) {
        int tid = threadIdx.x; asm volatile("" : "+v"(tid));
        const int lane = tid & 63, wave = __builtin_amdgcn_readfirstlane(tid >> 6);
        const int gw = blockIdx.x * 8 + wave;
        LAS float* scr = (LAS float*)(lds + wave * 8448);
        int cvw = gw;
        typedef const __attribute__((address_space(4))) Args* ArgsP;
        ArgsP ap = (ArgsP)__builtin_amdgcn_kernarg_segment_ptr(); asm volatile("" : "+s"(ap));
        unsigned char* ws = ap->ws;
        bf16_t* WR = (bf16_t*)(ws + OFF_W);
        float* dtbuf = (float*)(ws + OFF_DT); float* vsq = (float*)(ws + OFF_VSQ); float* cdec = (float*)(ws + OFF_CDEC);
        bf16_t* Hb = (bf16_t*)(ws + OFF_A(0));
        const int l = ph == 0 ? 0 : (ph - 1) / NPH_LAYER;
        const int p = ph == 0 ? -1 : (ph - 1) % NPH_LAYER;

        const int pc = p < 0 ? 20 : p;
        if (p == 11) continue;
        if (p == 9 || p == 14 || p == 20) continue;
#ifdef DBG_REPMASK
        const bool ALT = ((DBG_REPMASK >> pc) & 1) && (DBG_REP_LMASK >> l & 1) && !redo && (pc == 1 || pc == 2 || pc == 3 || pc == 5);
#else
        constexpr bool ALT = false;
#endif
#ifdef DBG_SKIP
#define SKIP(b) (ALT && ((DBG_SKIP) & (b)))
#else
#define SKIP(b) false
#endif
        const bool gemm = p >= 0 && GDT[pc].isgemm != 0;
        if (p == 8 || p == 13 || p == 19) {
            const GD* d = &GDT[pc];
            const pg8::Gemm gd{(const bf16_t*)(ws + d->a), (const bf16_t*)(ws + d->b), d->M, d->N, d->K};
            const int site = l * 3 + (p == 8 ? 0 : (p == 13 ? 1 : 2));
            unsigned* xc = (unsigned*)(ws + OFF_XCNT); unsigned* xb = (unsigned*)(ws + OFF_XBUF);
            EpiNorm E;
            E.xsrc = (p == 8 && l == 0) ? ap->in[0] : (const float*)ap->out; E.xdst = ap->out; E.H = Hb;
            E.gpost = (p == 8 ? ap->in[3] : (p == 13 ? ap->in[6] : ap->in[8])) + l * DM;
            E.pre = !(p == 19 && l == 1);
            E.gpre = p == 8 ? ap->in[4] + l * DM : (p == 13 ? ap->in[7] + l * DM : ap->in[2] + DM);
            E.x1 = RmsXchg{xb + (size_t)(2 * site) * 65536, xc + (size_t)(2 * site) * 4096};
            E.x2 = RmsXchg{xb + (size_t)(2 * site + 1) * 65536, xc + (size_t)(2 * site + 1) * 4096};
            pg8::StaticOrder S; S.init(gd.M, gd.N, G, (int)blockIdx.x);
            pg8::gemm_phase<EpiNorm, pg8::StaticOrder>(lds, gd, S, E);
            __syncthreads();
            if (p == 8) {
                cv_job(ap->in[22] + (size_t)l * 1024 * 1024, 1024, 1024, 0, 1024, (bf16_t*)(ws + OFF_W), 0, false, scr, cvw, NGW, lane);
                cv_job(ap->in[24] + (size_t)l * 1024 * 1024, 1024, 1024, 0, 1024, (bf16_t*)(ws + OFF_W + 22 * MiB), 0, false, scr, cvw, NGW, lane);
            } else if (p == 13) {
                cv_job(ap->in[25] + (size_t)l * 1024 * 5632, 1024, 5632, 0, 5632, (bf16_t*)(ws + OFF_W), 0, true, scr, cvw, NGW, lane);
                cv_job(ap->in[28] + (size_t)l * 2816 * 1024, 2816, 1024, 0, 1024, (bf16_t*)(ws + OFF_W + 12 * MiB), 0, false, scr, cvw, NGW, lane);
            } else if (l == 0) {
                const int lw = 1;
                cv_job(ap->in[9] + (size_t)lw * 1024 * 9248, 1024, 9248, 2048, 5152, WR, 0, false, scr, cvw, NGW, lane);
                cv_job(ap->in[23] + (size_t)lw * 1024 * 2048, 1024, 2048, 0, 2048, (bf16_t*)(ws + OFF_WKV), 0, false, scr, cvw, NGW, lane);
                norm_rows<false, true>(ap->in[1], nullptr, nullptr, nullptr, ap->in[5] + lw * DM, (bf16_t*)(ws + OFF_MEMN), 1024, gw, NGW, lane);
                for (int i = blockIdx.x * 512 + tid; i < 28672; i += G * 512) ((u32x4*)(WR + (size_t)5152 * 1024))[i] = (u32x4){0u, 0u, 0u, 0u};
            }
        } else if (gemm) {
            const GD* d = &GDT[pc];
            const pg8::Gemm gd{(const bf16_t*)(ws + d->a), (const bf16_t*)(ws + d->b), d->M, d->N, d->K};
            EpiGen E; E.d = d; E.ws = ws; E.f32o = dtbuf; E.bias = ap->in[15] + l * 32; E.sq = vsq;
            pg8::StaticOrder S; S.init(gd.M, gd.N, G, (int)blockIdx.x);
            if (pc == 0) { S.nextra = 32; S.xm = 4; S.pm0 = 64; S.pn0 = 21; S.A2 = (const char*)(ws + OFF_MEMN); S.B2 = (const char*)(ws + OFF_WKV); }
            pg8::gemm_phase<EpiGen, pg8::StaticOrder>(lds, gd, S, E);
        } else if (p == -1) {
            if (p == -1) {
                norm_rows<false, true>(ap->in[0], nullptr, nullptr, nullptr, ap->in[2], Hb, T_TOK, gw, NGW, lane);
            }
            {
                const int lw = p == -1 ? 0 : 1;
                cv_job(ap->in[9] + (size_t)lw * 1024 * 9248, 1024, 9248, 2048, 5152, WR, 0, false, scr, cvw, NGW, lane);
                cv_job(ap->in[23] + (size_t)lw * 1024 * 2048, 1024, 2048, 0, 2048, (bf16_t*)(ws + OFF_WKV), 0, false, scr, cvw, NGW, lane);
                norm_rows<false, true>(ap->in[1], nullptr, nullptr, nullptr, ap->in[5] + lw * DM, (bf16_t*)(ws + OFF_MEMN), 1024, gw, NGW, lane);
                for (int i = blockIdx.x * 512 + tid; i < 28672; i += G * 512) ((u32x4*)(WR + (size_t)5152 * 1024))[i] = (u32x4){0u, 0u, 0u, 0u};
            }
        } else if (p == 1) {
            LAS float* wsc = (LAS float*)lds; LAS unsigned char* Bc = lds + 4096; LAS unsigned char* Xw = lds + 38912;
            const unsigned BcA = lds_addr(Bc), XwA = lds_addr(Xw);
            const bf16_t* XBC = (const bf16_t*)(ws + OFF_A(3)); bf16_t* states = (bf16_t*)(ws + OFF_A(6));
            const float* cw = ap->in[13] + (size_t)l * 4 * 3072; const float* cb = ap->in[14] + (size_t)l * 3072;
            for (int u = blockIdx.x; u < 512; u += G) {
                int tl_ = tid; asm volatile("" : "+v"(tl_)); const int tid = tl_, lane = tl_ & 63;
                const int g = u & 3, bc = u >> 2, rowbase = bc * 128; const bool first = (bc & 31) == 0;
                { const int h = g * 8 + wave; const float a = -__expf(ap->in[16][l * 32 + h]); float d0, d1, c0, c1, tot;
                  ssd_dt_scan(dtbuf, rowbase, h, a, lane, d0, d1, c0, c1, tot);
                  wsc[wave * 128 + 2 * lane] = __expf(tot - c0) * d0; wsc[wave * 128 + 2 * lane + 1] = __expf(tot - c1) * d1;
                  if (lane == 0) cdec[bc * 32 + h] = __expf(tot); }
                const bf16_t* raw = XBC + (size_t)rowbase * 3072;
                load_conv_tile<128, false>(Bc, 272, raw, 2048 + g * 128, first, cw, cb, nullptr, tid);
                __syncthreads();
#pragma unroll 1
                for (int quad = 0; quad < 2; ++quad) {
                    if (!SKIP(32)) load_conv_tile<256, true>(Xw, 528, raw, g * 512 + quad * 256, first, cw, cb, wsc + quad * 512, tid);
                    __syncthreads();
                    const int hl = wave >> 1, nh = wave & 1;
                    if (!SKIP(64)) {
                    f32x4 acc[4][4];
#pragma unroll
                    for (int i = 0; i < 4; ++i)
#pragma unroll
                        for (int j = 0; j < 4; ++j) acc[i][j] = (f32x4){0.f, 0.f, 0.f, 0.f};
#pragma unroll 1
                    for (int ks = 0; ks < 4; ++ks) {
                        bf16x8 A[4], B[4];
                        frag_tr_x4<true>(BcA, 272, 32 * ks, 64 * nh, 16, lane, 8, 4, A); frag_tr_x4(XwA, 528, 32 * ks, 64 * hl, 16, lane, 8, 4, B);
#pragma unroll
                        for (int i = 0; i < 4; ++i)
#pragma unroll
                            for (int j = 0; j < 4; ++j) acc[i][j] = mfma16(A[i], B[j], acc[i][j]);
                    }
                    const int h = g * 8 + quad * 4 + hl; bf16_t* Sp = states + ((size_t)(bc * 32 + h) << 13);
#pragma unroll
                    for (int i = 0; i < 4; ++i)
#pragma unroll
                        for (int j = 0; j < 4; ++j) { const int pp = 16 * j + (lane & 15), n = 64 * nh + PPERM(i) + 8 * (lane >> 4);
                            u32x2 w; w.x = pk2(acc[i][j][0], acc[i][j][1]); w.y = pk2(acc[i][j][2], acc[i][j][3]); if (!SKIP(256)) *(u32x2*)(Sp + pp * 128 + n) = w; else if (w.x == 0x12345678u) cdec[0] = 1.f; }
                    }
                    __syncthreads();
                }
            }
        } else if (p == 2) {
            bf16_t* states = (bf16_t*)(ws + OFF_A(6)); bf16_t* sout = ALT ? (bf16_t*)ap->out : states;
            for (int i = blockIdx.x * 512 + tid; i < 131072; i += G * 512) {
                const int e8 = i & 1023, h = (i >> 10) & 31, b = i >> 15;
                float f[8];
#pragma unroll
                for (int e = 0; e < 8; ++e) f[e] = 0.f;
#pragma unroll 1
                for (int c0 = 0; c0 < 32; c0 += 8) {
                    u32x4 stv[8]; float decv[8];
#pragma unroll
                    for (int k = 0; k < 8; ++k) { stv[k] = *(const u32x4*)(states + ((size_t)((b * 32 + c0 + k) * 32 + h) << 13) + e8 * 8); decv[k] = cdec[(b * 32 + c0 + k) * 32 + h]; }
#pragma unroll
                    for (int k = 0; k < 8; ++k) {
                        const u32x4 st = stv[k]; const float dec = decv[k];
                        u32x4 o; o.x = pk2(f[0], f[1]); o.y = pk2(f[2], f[3]); o.z = pk2(f[4], f[5]); o.w = pk2(f[6], f[7]);
                        *(u32x4*)(sout + ((size_t)((b * 32 + c0 + k) * 32 + h) << 13) + e8 * 8) = o;
                        f[0] = f[0] * dec + bflo(st.x); f[1] = f[1] * dec + bfhi(st.x); f[2] = f[2] * dec + bflo(st.y); f[3] = f[3] * dec + bfhi(st.y);
                        f[4] = f[4] * dec + bflo(st.z); f[5] = f[5] * dec + bfhi(st.z); f[6] = f[6] * dec + bflo(st.w); f[7] = f[7] * dec + bfhi(st.w);
                    }
                }
            }
            const float* Win = ap->in[9] + (size_t)l * 1024 * 9248;
            cv_job(Win, 1024, 9248, 0, 2048, WR, 0, false, scr, cvw, NGW, lane);
            cv_job(Win, 1024, 9248, 7200, 2048, WR, 2048, false, scr, cvw, NGW, lane);
            cv_job(ap->in[19] + (size_t)l * 1024 * 1024, 1024, 1024, 0, 1024, (bf16_t*)(ws + OFF_W + 8 * MiB), 0, false, scr, cvw, NGW, lane);
            cv_job(ap->in[20] + (size_t)l * 2048 * 1024, 2048, 1024, 0, 1024, (bf16_t*)(ws + OFF_W + 10 * MiB), 0, false, scr, cvw, NGW, lane);
            cv_job(ap->in[21] + (size_t)l * 1024 * 1024, 1024, 1024, 0, 1024, (bf16_t*)(ws + OFF_W + 14 * MiB), 0, false, scr, cvw, NGW, lane);
        } else if (p == 3) {
            LAS float* acs = (LAS float*)lds; LAS float* dtv = (LAS float*)(lds + 4096); LAS float* rsq = (LAS float*)(lds + 8192);
            LAS unsigned char* Cc = lds + 12288; LAS unsigned char* Sc = lds + 47104; LAS unsigned char* Xt = lds + 81920;
            const unsigned XtA = lds_addr(Xt);
            const bf16_t* XBC = (const bf16_t*)(ws + OFF_A(3)); const bf16_t* states = (const bf16_t*)(ws + OFF_A(6)); bf16_t* Y = ALT ? (bf16_t*)ap->out : (bf16_t*)(ws + OFF_A(1)); const bf16_t* Zin = (const bf16_t*)(ws + OFF_A(1));
            const float* cw = ap->in[13] + (size_t)l * 4 * 3072; const float* cb = ap->in[14] + (size_t)l * 3072;
            const float* ng = ap->in[18] + (size_t)l * 2048;
            for (int u = blockIdx.x; u < 512; u += G) {
                int tl_ = tid; asm volatile("" : "+v"(tl_)); const int tid = tl_, lane = tl_ & 63;
                const int g = u & 3, bc = u >> 2, rowbase = bc * 128; const bool first = (bc & 31) == 0;
                { const int h = g * 8 + wave; const float a = -__expf(ap->in[16][l * 32 + h]); float d0, d1, c0, c1, tot;
                  ssd_dt_scan(dtbuf, rowbase, h, a, lane, d0, d1, c0, c1, tot);
                  acs[wave * 128 + 2 * lane] = c0; acs[wave * 128 + 2 * lane + 1] = c1; dtv[wave * 128 + 2 * lane] = d0; dtv[wave * 128 + 2 * lane + 1] = d1; }
                const bf16_t* raw = XBC + (size_t)rowbase * 3072;
                if (!SKIP(16)) {
                load_conv_tile<128, false>(Cc, 272, raw, 2560 + g * 128, first, cw, cb, nullptr, tid);
                load_conv_tile<128, false>(Xt, 272, raw, 2048 + g * 128, first, cw, cb, nullptr, tid);
                }
                __syncthreads();
                {
                    const int jt = wave;
                    for (int it = 0; it <= jt; ++it) {
                        f32x4 acc = (f32x4){0.f, 0.f, 0.f, 0.f};
#pragma unroll
                        for (int ks = 0; ks < 4; ++ks) acc = mfma16(frag_row(Xt, 272, 16 * it, 32 * ks, lane), frag_row(Cc, 272, 16 * jt, 32 * ks, lane), acc);
                        u32x2 w; w.x = pk2(acc[0], acc[1]); w.y = pk2(acc[2], acc[3]);
                        *(LAS u32x2*)(Sc + (16 * jt + (lane & 15)) * 272 + (16 * it + 4 * (lane >> 4)) * 2) = w;
                    }
                }
                __syncthreads();
                const int hl = wave & 3, lh = wave >> 2;
                u32x2 keep[2][4][4];
#pragma unroll
                for (int quad = 0; quad < 2; ++quad) {
                    const int hh8 = quad * 4 + hl, h = g * 8 + hh8;
                    const bf16_t* prevp = states + ((size_t)(bc * 32 + h) << 13);
                    if (!SKIP(4)) load_conv_tile<256, false>(Xt, 528, raw, g * 512 + quad * 256, first, cw, cb, nullptr, tid);
#if 0
                    bf16x8 PA[2][4];
#pragma unroll
                    for (int ks = 0; ks < 2; ++ks)
#pragma unroll
                        for (int i = 0; i < 4; ++i) PA[ks][i] = *(const bf16x8*)(prevp + (PPERM(i) + 8 * ((lane & 15) >> 2) + (lane & 3)) * 128 + 32 * ks + 8 * (lane >> 4));
#define PAF(ks, i) PA[(ks) & 1][i]
#else
#define PAF(ks, i) (*(const bf16x8*)(prevp + (PPERM(i) + 8 * ((lane & 15) >> 2) + (lane & 3)) * 128 + 32 * (ks) + 8 * (lane >> 4)))
#endif
                    __syncthreads();
                    f32x4 acc[4][4];
#pragma unroll
                    for (int i = 0; i < 4; ++i)
#pragma unroll
                        for (int j = 0; j < 4; ++j) acc[i][j] = (f32x4){0.f, 0.f, 0.f, 0.f};
#if 0
                    bf16x8 PB[2][4];
#pragma unroll
                    for (int ks = 0; ks < 2; ++ks)
#pragma unroll
                        for (int i = 0; i < 4; ++i) PB[ks][i] = *(const bf16x8*)(prevp + (PPERM(i) + 8 * ((lane & 15) >> 2) + (lane & 3)) * 128 + 32 * (ks + 2) + 8 * (lane >> 4));
#define PBF(ks, i) PB[(ks) & 1][i]
#else
#define PBF(ks, i) (*(const bf16x8*)(prevp + (PPERM(i) + 8 * ((lane & 15) >> 2) + (lane & 3)) * 128 + 32 * (ks) + 8 * (lane >> 4)))
#endif
#pragma unroll 1
                    for (int ks = 0; ks < (SKIP(2) ? 0 : 4); ++ks) {
                        bf16x8 B[4];
#pragma unroll
                        for (int i = 0; i < 4; ++i) B[i] = frag_row(Cc, 272, 64 * lh + 16 * i, 32 * ks, lane);
#pragma unroll
                        for (int i = 0; i < 4; ++i)
#pragma unroll
                            for (int j = 0; j < 4; ++j) acc[i][j] = mfma16(ks < 2 ? PAF(ks, i) : PBF(ks, i), B[j], acc[i][j]);
                    }
#pragma unroll
                    for (int j = 0; j < 4; ++j) { const float e = __expf(acs[hh8 * 128 + 64 * lh + 16 * j + (lane & 15)]);
#pragma unroll
                        for (int i = 0; i < 4; ++i) acc[i][j] *= e; }
#pragma unroll 1
#ifdef DBG_NO_YDIAG
#define DBG_KDIAG -1
#else
#define DBG_KDIAG (2 * lh + 1)
#endif
                    for (int ks = 0; ks <= (SKIP(1) ? -1 : DBG_KDIAG); ++ks) {
                        bf16x8 A[4];
                        frag_tr_x4<true>(XtA, 528, 32 * ks, 64 * hl, 16, lane, 8, 4, A);
#pragma unroll
                        for (int j = 0; j < 4; ++j) {
                            const int l0 = 64 * lh + 16 * j;
                            if (32 * ks > l0 + 15) continue;
                            const bf16x8 scv = frag_row(Sc, 272, l0, 32 * ks, lane);
                            const u32x4 scu = __builtin_bit_cast(u32x4, scv);
                            const int li = l0 + (lane & 15), sb = 32 * ks + 8 * (lane >> 4);
                            const float al = acs[hh8 * 128 + li];
                            const f32x4 as0 = *(const LAS f32x4*)(acs + hh8 * 128 + sb), as1 = *(const LAS f32x4*)(acs + hh8 * 128 + sb + 4);
                            const f32x4 dd0 = *(const LAS f32x4*)(dtv + hh8 * 128 + sb), dd1 = *(const LAS f32x4*)(dtv + hh8 * 128 + sb + 4);
                            float f[8];
                            f[0] = bflo(scu.x); f[1] = bfhi(scu.x); f[2] = bflo(scu.y); f[3] = bfhi(scu.y); f[4] = bflo(scu.z); f[5] = bfhi(scu.z); f[6] = bflo(scu.w); f[7] = bfhi(scu.w);
#pragma unroll
                            for (int e = 0; e < 4; ++e) {
                                f[e] = (sb + e <= li) ? f[e] : 0.f; f[4 + e] = (sb + 4 + e <= li) ? f[4 + e] : 0.f;
                                f[e] *= __expf(fminf(al - as0[e], 0.f)) * dd0[e]; f[4 + e] *= __expf(fminf(al - as1[e], 0.f)) * dd1[e];
                            }
                            u32x4 bm; bm.x = pk2(f[0], f[1]); bm.y = pk2(f[2], f[3]); bm.z = pk2(f[4], f[5]); bm.w = pk2(f[6], f[7]);
                            const bf16x8 Bm = __builtin_bit_cast(bf16x8, bm);
#pragma unroll
                            for (int i = 0; i < 4; ++i) acc[i][j] = mfma16(A[i], Bm, acc[i][j]);
                        }
                    }
                    const float Dh = ap->in[17][l * 32 + h];
                    if (!SKIP(8)) {
                    u32x2 zall[4][4];
#pragma unroll
                    for (int j = 0; j < 4; ++j)
#pragma unroll
                        for (int i = 0; i < 4; ++i) zall[j][i] = *(const u32x2*)(Zin + (size_t)(rowbase + 64 * lh + 16 * j + (lane & 15)) * 2048 + h * 64 + PPERM(i) + 8 * (lane >> 4));
#pragma unroll
                    for (int j = 0; j < 4; ++j) {
                        const int li = 64 * lh + 16 * j + (lane & 15); float ssq = 0.f;
#pragma unroll
                        for (int i = 0; i < 4; ++i) {
                            const int pp = PPERM(i) + 8 * (lane >> 4);
                            const u32x2 xv = *(const LAS u32x2*)(Xt + li * 528 + (64 * hl + pp) * 2);
                            u32x2* zp = (u32x2*)(Y + (size_t)(rowbase + li) * 2048 + h * 64 + pp); const u32x2 zv = zall[j][i];
                            const float v0 = (acc[i][j][0] + Dh * bflo(xv.x)) * bflo(zv.x), v1 = (acc[i][j][1] + Dh * bfhi(xv.x)) * bfhi(zv.x);
                            const float v2 = (acc[i][j][2] + Dh * bflo(xv.y)) * bflo(zv.y), v3 = (acc[i][j][3] + Dh * bfhi(xv.y)) * bfhi(zv.y);
                            ssq += (v0 * v0 + v1 * v1) + (v2 * v2 + v3 * v3);
                            u32x2 w; w.x = pk2(v0, v1); w.y = pk2(v2, v3); keep[quad][j][i] = w; (void)zp;
                        }
                        ssq += __shfl_xor(ssq, 16); ssq += __shfl_xor(ssq, 32);
                        if ((lane >> 4) == 0) rsq[hh8 * 128 + li] = ssq;
                    }
                    }
                    __syncthreads();
                }
#ifndef DBG_NOFIX
#define DBG_FIXQ 2
#else
#define DBG_FIXQ 0
#endif
#pragma unroll
                for (int quad = 0; quad < 2; ++quad) {
                    if (SKIP(8)) continue;
                    const int h = g * 8 + quad * 4 + hl;
#pragma unroll
                    for (int j = 0; j < 4; ++j) {
                        const int li = 64 * lh + 16 * j + (lane & 15); float s = 0.f;
#pragma unroll
                        for (int k = 0; k < 8; ++k) s += rsq[k * 128 + li];
                        const float r = rsqrtf(s * (1.f / 512.f) + EPS);
#pragma unroll
                        for (int i = 0; i < 4; ++i) {
                            const int pp = PPERM(i) + 8 * (lane >> 4);
                            const u32x2 zv = keep[quad][j][i];
                            const f32x4 gn = *(const f32x4*)(ng + h * 64 + pp);
                            u32x2 w; w.x = pk2(bflo(zv.x) * r * gn[0], bfhi(zv.x) * r * gn[1]); w.y = pk2(bflo(zv.y) * r * gn[2], bfhi(zv.y) * r * gn[3]);
                            *(LAS u32x2*)(Cc + li * 1040 + ((quad * 4 + hl) * 64 + pp) * 2) = w;
                        }
                    }
                }
                __syncthreads();
#pragma unroll
                for (int i = 0; i < 16; ++i) { const int row = (tid >> 6) + 8 * i;
                    *(u32x4*)(Y + (size_t)(rowbase + row) * 2048 + g * 512 + (tid & 63) * 8) = *(const LAS u32x4*)(Cc + row * 1040 + (tid & 63) * 16); }
                __syncthreads();
            }
        } else if (p == 5) {
            LAS unsigned char* Wt = lds; LAS unsigned char* Vt = lds + 34816; LAS float* rs = (LAS float*)(lds + 69632);
            const unsigned VtA = lds_addr(Vt);
            const float* Wsp = ap->in[11] + (size_t)l * 8 * 128 * 128; const float* bs = ap->in[12] + (size_t)l * 8 * 128; const float* gain = ap->in[10] + (size_t)l * 1024;
            bf16_t* Ug = ALT ? (bf16_t*)ap->out : (bf16_t*)(ws + OFF_A(3)); const bf16_t* Uin = (const bf16_t*)(ws + OFF_A(3)); const bf16_t* Vg = (const bf16_t*)(ws + OFF_A(4));
            for (int u = blockIdx.x; u < 1024; u += G) {
                int tl_ = tid; asm volatile("" : "+v"(tl_)); const int tid = tl_, lane = tl_ & 63;
                const int g = u & 7, bc = u >> 3, rowbase = bc * 128;
                f32x4 wreg[8]; u32x4 vreg[4];
#pragma unroll
                for (int i = 0; i < 8; ++i) { const int idx = tid + 512 * i, t = idx >> 5, s4 = (idx & 31) * 4; wreg[i] = *(const f32x4*)(Wsp + (size_t)(g * 128 + t) * 128 + s4); }
#pragma unroll
                for (int i = 0; i < 4; ++i) { const int idx = tid + 512 * i, s = idx >> 4, c8 = (idx & 15) * 8; vreg[i] = *(const u32x4*)(Vg + (size_t)(rowbase + s) * 1024 + g * 128 + c8); }
                if (tid < 128) { const f32x4* pp = (const f32x4*)(vsq + (size_t)(rowbase + tid) * 16); const f32x4 a = pp[0], b = pp[1], c = pp[2], d = pp[3];
                    const float s = ((a[0] + a[1]) + (a[2] + a[3])) + ((b[0] + b[1]) + (b[2] + b[3])) + ((c[0] + c[1]) + (c[2] + c[3])) + ((d[0] + d[1]) + (d[2] + d[3]));
                    rs[tid] = rsqrtf(s * (1.f / 1024.f) + EPS); }
                __syncthreads();
#pragma unroll
                for (int i = 0; i < 8; ++i) { const int idx = tid + 512 * i, t = idx >> 5, s4 = (idx & 31) * 4;
                    f32x4 w = wreg[i]; const f32x4 r4 = *(const LAS f32x4*)(rs + s4);
#pragma unroll
                    for (int e = 0; e < 4; ++e) w[e] = (s4 + e <= t) ? w[e] * r4[e] : 0.f;
                    u32x2 o; o.x = pk2(w[0], w[1]); o.y = pk2(w[2], w[3]); *(LAS u32x2*)(Wt + t * 272 + s4 * 2) = o; }
#pragma unroll
                for (int i = 0; i < 4; ++i) { const int idx = tid + 512 * i, s = idx >> 4, c8 = (idx & 15) * 8; *(LAS u32x4*)(Vt + s * 272 + c8 * 2) = vreg[i]; }
                __syncthreads();
                const int t0 = 16 * wave, nks = (t0 + 15) / 32 + 1;
                u32x2 uall[8];
#pragma unroll
                for (int i = 0; i < 8; ++i) uall[i] = *(const u32x2*)(Uin + (size_t)(rowbase + t0 + (lane & 15)) * 1024 + g * 128 + 16 * i + 4 * (lane >> 4));
                f32x4 acc[8];
#pragma unroll
                for (int i = 0; i < 8; ++i) acc[i] = (f32x4){0.f, 0.f, 0.f, 0.f};
#pragma unroll 1
                for (int ks = 0; ks < nks; ++ks) {
                    const bf16x8 b = frag_row(Wt, 272, t0, 32 * ks, lane);
                    bf16x8 va[4], vb[4];
                    frag_tr_x4(VtA, 272, 32 * ks, 0, 16, lane, 8, 4, va); frag_tr_x4(VtA, 272, 32 * ks, 64, 16, lane, 8, 4, vb);
#pragma unroll
                    for (int i = 0; i < 4; ++i) { acc[i] = mfma16(va[i], b, acc[i]); acc[4 + i] = mfma16(vb[i], b, acc[4 + i]); }
                }
                const int t = t0 + (lane & 15); const float bsv = bs[g * 128 + t];
#pragma unroll
                for (int i = 0; i < 8; ++i) { const int d = 16 * i + 4 * (lane >> 4); const f32x4 gn = *(const f32x4*)(gain + g * 128 + d);
                    u32x2* up = (u32x2*)(Ug + (size_t)(rowbase + t) * 1024 + g * 128 + d); const u32x2 uv = uall[i];
                    u32x2 o; o.x = pk2((acc[i][0] * gn[0] + bsv) * bflo(uv.x), (acc[i][1] * gn[1] + bsv) * bfhi(uv.x));
                    o.y = pk2((acc[i][2] * gn[2] + bsv) * bflo(uv.y), (acc[i][3] * gn[3] + bsv) * bfhi(uv.y)); *up = o; }
                __syncthreads();
            }
        } else if (p == 12) {
            const unsigned LA = lds_addr(lds);
            const bf16_t* Q = (const bf16_t*)(ws + OFF_A(1)); const bf16_t* KV = (const bf16_t*)(ws + OFF_KV); bf16_t* O2 = (bf16_t*)(ws + OFF_A(4));
            for (int u = blockIdx.x; u < 256; u += G) {
                int tl_ = tid; asm volatile("" : "+v"(tl_)); const int tid = tl_, lane = tl_ & 63;
                const int qb = u & 15, h = (u >> 4) & 3, b = u >> 6;
                const bf16_t* Kg = KV + (size_t)(b * 256) * 2048 + h * 256;
#pragma unroll
                for (int i = 0; i < 16; ++i) { const int idx = tid + 512 * i, m = idx >> 5, c8 = (idx & 31) * 8; *(LAS u32x4*)(lds + m * 528 + c8 * 2) = *(const u32x4*)(Kg + (size_t)m * 2048 + c8); }
                const int q0 = b * 4096 + qb * 256 + 32 * wave;
                const bf16_t* Qp = Q + (size_t)(q0 + (lane & 15)) * 1024 + h * 256 + 8 * (lane >> 4);
                __syncthreads();
                f32x4 s[2][16];
#pragma unroll
                for (int t = 0; t < 2; ++t)
#pragma unroll
                    for (int mt = 0; mt < 16; ++mt) s[t][mt] = (f32x4){0.f, 0.f, 0.f, 0.f};
#pragma unroll 2
                for (int ks = 0; ks < 8; ++ks) {
                    const bf16x8 q0f = *(const bf16x8*)(Qp + 32 * ks), q1f = *(const bf16x8*)(Qp + 16 * 1024 + 32 * ks);
#pragma unroll
                    for (int mt = 0; mt < 16; ++mt) { const bf16x8 a = frag_row(lds, 528, 16 * mt, 32 * ks, lane); s[0][mt] = mfma16(a, q0f, s[0][mt]); s[1][mt] = mfma16(a, q1f, s[1][mt]); }
                }
                bf16x8 pb[2][8];
#pragma unroll
                for (int t = 0; t < 2; ++t) {
                    float mx = -3.0e38f;
#pragma unroll
                    for (int mt = 0; mt < 16; ++mt) mx = fmaxf(mx, fmaxf(fmaxf(s[t][mt][0], s[t][mt][1]), fmaxf(s[t][mt][2], s[t][mt][3])));
                    mx = fmaxf(mx, __shfl_xor(mx, 16)); mx = fmaxf(mx, __shfl_xor(mx, 32));
                    const float cs = 0.0625f * 1.44269504089f; float sum = 0.f;
#pragma unroll
                    for (int mt = 0; mt < 16; ++mt)
#pragma unroll
                        for (int e = 0; e < 4; ++e) { s[t][mt][e] = exp2f((s[t][mt][e] - mx) * cs); sum += s[t][mt][e]; }
                    sum += __shfl_xor(sum, 16); sum += __shfl_xor(sum, 32);
                    const float inv = __fdividef(1.f, sum);
#pragma unroll
                    for (int kb = 0; kb < 8; ++kb) { u32x4 w; w.x = pk2(s[t][2 * kb][0] * inv, s[t][2 * kb][1] * inv); w.y = pk2(s[t][2 * kb][2] * inv, s[t][2 * kb][3] * inv);
                        w.z = pk2(s[t][2 * kb + 1][0] * inv, s[t][2 * kb + 1][1] * inv); w.w = pk2(s[t][2 * kb + 1][2] * inv, s[t][2 * kb + 1][3] * inv); pb[t][kb] = __builtin_bit_cast(bf16x8, w); }
                }
                __syncthreads();
#pragma unroll
                for (int i = 0; i < 16; ++i) { const int idx = tid + 512 * i, m = idx >> 5, c8 = (idx & 31) * 8; *(LAS u32x4*)(lds + m * 528 + c8 * 2) = *(const u32x4*)(Kg + 1024 + (size_t)m * 2048 + c8); }
                __syncthreads();
#pragma unroll 1
                for (int dh = 0; dh < 2; ++dh) {
                    f32x4 o[2][8];
#pragma unroll
                    for (int t = 0; t < 2; ++t)
#pragma unroll
                        for (int i = 0; i < 8; ++i) o[t][i] = (f32x4){0.f, 0.f, 0.f, 0.f};
#pragma unroll
                    for (int kb = 0; kb < 8; ++kb) {
#pragma unroll
                        for (int d4 = 0; d4 < 2; ++d4) { bf16x8 vf[4]; frag_tr_x4(LA, 528, 32 * kb, 128 * dh + 64 * d4, 16, lane, 4, 16, vf);
#pragma unroll
                            for (int i = 0; i < 4; ++i) { o[0][4 * d4 + i] = mfma16(vf[i], pb[0][kb], o[0][4 * d4 + i]); o[1][4 * d4 + i] = mfma16(vf[i], pb[1][kb], o[1][4 * d4 + i]); } }
                    }
#pragma unroll
                    for (int t = 0; t < 2; ++t)
#pragma unroll
                        for (int i = 0; i < 8; ++i) { u32x2 w; w.x = pk2(o[t][i][0], o[t][i][1]); w.y = pk2(o[t][i][2], o[t][i][3]);
                            *(u32x2*)(O2 + (size_t)(q0 + 16 * t + (lane & 15)) * 1024 + h * 256 + 128 * dh + 16 * i + 4 * (lane >> 4)) = w; }
                }
                __syncthreads();
            }
        } else if (p == 16 || p == 18) {
            const int hh = p == 18 ? 1 : 0;
            const bf16_t* UP = (const bf16_t*)(ws + OFF_A(1)); bf16_t* Gb = (bf16_t*)(ws + OFF_A(4));
            const float* cw = ap->in[26] + (size_t)l * 3 * 5632; const float* cb = ap->in[27] + (size_t)l * 5632;
            for (int u = blockIdx.x; u < 11 * 64; u += G) {
                int tl_ = tid; asm volatile("" : "+v"(tl_)); const int tid = tl_, lane = tl_ & 63;
                const int jj = u % 11, tb = u / 11, cgi = tid & 15, tr = tid >> 4, t0 = tb * 256 + tr * 8, j = 11 * hh + jj;
                const int ca = 128 * j + 8 * cgi, cbb = 2816 + ca;
                float wa[3][8], wb[3][8], ba[8], bb[8];
#pragma unroll
                for (int k = 0; k < 3; ++k) { const f32x4 a0 = *(const f32x4*)(cw + k * 5632 + ca), a1 = *(const f32x4*)(cw + k * 5632 + ca + 4), b0 = *(const f32x4*)(cw + k * 5632 + cbb), b1 = *(const f32x4*)(cw + k * 5632 + cbb + 4);
#pragma unroll
                    for (int e = 0; e < 4; ++e) { wa[k][e] = a0[e]; wa[k][4 + e] = a1[e]; wb[k][e] = b0[e]; wb[k][4 + e] = b1[e]; } }
                { const f32x4 a0 = *(const f32x4*)(cb + ca), a1 = *(const f32x4*)(cb + ca + 4), b0 = *(const f32x4*)(cb + cbb), b1 = *(const f32x4*)(cb + cbb + 4);
#pragma unroll
                    for (int e = 0; e < 4; ++e) { ba[e] = a0[e]; ba[4 + e] = a1[e]; bb[e] = b0[e]; bb[4 + e] = b1[e]; } }
                const bf16_t* base = UP + (size_t)t0 * 2816 + 256 * jj + 8 * cgi;
                const bool seq0 = (t0 & 4095) == 0;
                u32x4 a2 = (u32x4){0u, 0u, 0u, 0u}, a1 = a2, b2 = a2, b1 = a2;
                if (!seq0) { a2 = *(const u32x4*)(base - 2 * 2816); a1 = *(const u32x4*)(base - 2816); b2 = *(const u32x4*)(base - 2 * 2816 + 128); b1 = *(const u32x4*)(base - 2816 + 128); }
                u32x4 arow[8], brow[8];
#pragma unroll
                for (int i = 0; i < 8; ++i) { arow[i] = *(const u32x4*)(base + (size_t)i * 2816); brow[i] = *(const u32x4*)(base + (size_t)i * 2816 + 128); }
#pragma unroll
                for (int i = 0; i < 8; ++i) {
                    const u32x4 a0 = arow[i], b0 = brow[i];
                    float ga[8], gb[8];
#define UNP(dst, k, src) dst[0] += k[0] * bflo(src.x); dst[1] += k[1] * bfhi(src.x); dst[2] += k[2] * bflo(src.y); dst[3] += k[3] * bfhi(src.y); dst[4] += k[4] * bflo(src.z); dst[5] += k[5] * bfhi(src.z); dst[6] += k[6] * bflo(src.w); dst[7] += k[7] * bfhi(src.w);
#pragma unroll
                    for (int e = 0; e < 8; ++e) { ga[e] = ba[e]; gb[e] = bb[e]; }
                    UNP(ga, wa[0], a2) UNP(ga, wa[1], a1) UNP(ga, wa[2], a0)
                    UNP(gb, wb[0], b2) UNP(gb, wb[1], b1) UNP(gb, wb[2], b0)
#undef UNP
                    float r[8];
#pragma unroll
                    for (int e = 0; e < 8; ++e) r[e] = gelu_f(ga[e]) * gb[e];
                    u32x4 o; o.x = pk2(r[0], r[1]); o.y = pk2(r[2], r[3]); o.z = pk2(r[4], r[5]); o.w = pk2(r[6], r[7]);
                    *(u32x4*)(Gb + (size_t)(t0 + i) * 2816 + ca) = o;
                    a2 = a1; a1 = a0; b2 = b1; b1 = b0;
                }
            }
        }
#if !PER_PHASE_LAUNCH
        if (ph + 1 < ap->hi && p != 5 && !(l == 1 && p == 19)) { if (ap->lo < 0) grid.sync(); xcd_barrier(xbar); }
#ifdef DBG_REPMASK
        if (((DBG_REPMASK >> pc) & 1) && (DBG_REP_LMASK >> l & 1) && !redo) { redo = 1; --ph; } else redo = 0;
#endif
#endif
    }
}

extern "C" void kernel_launch(void* const* d_in, const int* in_sizes, int n_in, void* d_out, int out_size, void* d_ws, size_t ws_size, hipStream_t stream) {
    static int grid = 0;
    if (grid == 0) {
        if (n_in != 29 || out_size != T_TOK * DM || ws_size < WS_END) { fprintf(stderr, "kernel_launch: unexpected problem (n_in %d, out %d, ws %zu < %zu)\n", n_in, out_size, ws_size, (size_t)WS_END); grid = -1; return; }
        int dev = 0, cus = 0, per_cu = 0;
        hipGetDevice(&dev); hipDeviceGetAttribute(&cus, hipDeviceAttributeMultiprocessorCount, dev);
        if (hipFuncSetAttribute((const void*)fwd_megakernel, hipFuncAttributeMaxDynamicSharedMemorySize, LDS_BYTES) != hipSuccess) fprintf(stderr, "kernel_launch: hipFuncSetAttribute failed\n");
        if (hipOccupancyMaxActiveBlocksPerMultiprocessor(&per_cu, (const void*)fwd_megakernel, 512, LDS_BYTES) != hipSuccess || per_cu < 1) { fprintf(stderr, "kernel_launch: occupancy query gave %d\n", per_cu); per_cu = 1; }
        (void)hipGetLastError();
        grid = cus * 1;
    }
    if (grid < 0) return;
    Args a{};
    for (int i = 0; i < 29; ++i) a.in[i] = (const float*)d_in[i];
    a.out = (float*)d_out; a.ws = (unsigned char*)d_ws;
#if PER_PHASE_LAUNCH
    for (int ph = 0; ph < NPHASES; ++ph) { a.lo = ph; a.hi = ph + 1; hipLaunchKernelGGL(fwd_megakernel, dim3(grid), dim3(512), LDS_BYTES, stream, a); }
#else
    a.lo = 0; a.hi = NPHASES;
    (void)hipMemsetAsync((unsigned char*)d_ws + OFF_BAR, 0, (OFF_XBUF - OFF_BAR), stream);
    void* kargs[] = {&a};
    hipError_t e = hipLaunchCooperativeKernel((const void*)fwd_megakernel, dim3(grid), dim3(512), kargs, LDS_BYTES, stream);
    if (e != hipSuccess) fprintf(stderr, "cooperative launch failed: %s (grid %d)\n", hipGetErrorString(e), grid);
#endif
}
```
